# Optimizing an MI355X kernel written in HIP

```python
import jax, jax.numpy as jnp
from jax import lax
import numpy as np

D_MODEL = 1024
BATCH = 16
SEQ = 4096
DEPTH = 2

MLA_HEADS = 8
MLA_NOPE = 64
MLA_ROPE = 32
MLA_V = 64
MLA_Q_RANK = 256
MLA_KV_RANK = 128
Q_BLOCK = 128
CONV_CH = 512
CONV_WIDTH = 31
RET_HEADS = 4
RET_DK = 128
RET_DV = 256
RET_CHUNK = 128
FFN_HIDDEN = -(-8 * D_MODEL // (3 * 256)) * 256
N_BRANCH = 3
ROPE_BASE = 10000.0
EPS = 1e-6

IN_SPLITS = (MLA_Q_RANK, MLA_KV_RANK, MLA_ROPE, 2 * CONV_CH,
             RET_HEADS * RET_DK, RET_HEADS * RET_DK, RET_HEADS * RET_DV, RET_HEADS * RET_DV,
             N_BRANCH * D_MODEL)
IN_COLS = (MLA_Q_RANK + MLA_KV_RANK + MLA_ROPE + 2 * CONV_CH + 2 * RET_HEADS * RET_DK
           + 2 * RET_HEADS * RET_DV + N_BRANCH * D_MODEL)

kernel_name = "hybrid_mla_conformer_retention_encoder"


def rms_norm(x, g):
    xf = x.astype(jnp.float32)
    y = xf * lax.rsqrt(jnp.mean(xf * xf, -1, keepdims=True) + EPS)
    return (y * g.astype(jnp.float32)).astype(x.dtype)


def layer_norm(x, g, b):
    xf = x.astype(jnp.float32)
    mu = jnp.mean(xf, -1, keepdims=True)
    var = jnp.mean(jnp.square(xf - mu), -1, keepdims=True)
    y = (xf - mu) * lax.rsqrt(var + EPS)
    return (y * g.astype(jnp.float32) + b.astype(jnp.float32)).astype(x.dtype)


def rope_tables(positions, dim):
    inv = ROPE_BASE ** (-jnp.arange(0, dim, 2, dtype=jnp.float32) / dim)
    ang = positions.astype(jnp.float32)[..., None] * inv
    return jnp.cos(ang), jnp.sin(ang)


def apply_rope(x, cos, sin):
    if x.ndim == 4:
        cos, sin = cos[:, :, None, :], sin[:, :, None, :]
    cos, sin = cos.astype(x.dtype), sin.astype(x.dtype)
    x1, x2 = jnp.split(x, 2, axis=-1)
    return jnp.concatenate([x1 * cos - x2 * sin, x2 * cos + x1 * sin], axis=-1)


def mla_branch(c_q, c_kv, k_pe, cos, sin, q_norm, w_uq, kv_norm, w_ukv, w_o):
    B, S, _ = c_q.shape
    q = (rms_norm(c_q, q_norm) @ w_uq).reshape(B, S, MLA_HEADS, MLA_NOPE + MLA_ROPE)
    q_nope = q[..., :MLA_NOPE]
    q_pe = apply_rope(q[..., MLA_NOPE:], cos, sin)
    kv = (rms_norm(c_kv, kv_norm) @ w_ukv).reshape(B, S, MLA_HEADS, MLA_NOPE + MLA_V)
    k_nope, v = kv[..., :MLA_NOPE], kv[..., MLA_NOPE:]
    k_pe = apply_rope(k_pe, cos, sin)
    scale = (MLA_NOPE + MLA_ROPE) ** -0.5
    nq = S // Q_BLOCK
    qn_b = q_nope.reshape(B, nq, Q_BLOCK, MLA_HEADS, MLA_NOPE).swapaxes(0, 1)
    qp_b = q_pe.reshape(B, nq, Q_BLOCK, MLA_HEADS, MLA_ROPE).swapaxes(0, 1)

    def block(args):
        qn, qp = args
        s = (jnp.einsum('bqhd,bkhd->bhqk', qn, k_nope)
             + jnp.einsum('bqhr,bkr->bhqk', qp, k_pe))
        p = jax.nn.softmax(s.astype(jnp.float32) * scale, axis=-1).astype(v.dtype)
        return jnp.einsum('bhqk,bkhd->bqhd', p, v)

    o = lax.map(block, (qn_b, qp_b))
    o = o.swapaxes(0, 1).reshape(B, S, MLA_HEADS * MLA_V)
    return o @ w_o


def conv_branch(u, w_dw, b_dw, ln_g, ln_b, w_pw):
    a, gate = jnp.split(u, 2, axis=-1)
    a = a * jax.nn.sigmoid(gate)
    y = lax.conv_general_dilated(
        a, w_dw[:, None, :].astype(a.dtype), window_strides=(1,),
        padding=[(CONV_WIDTH // 2, CONV_WIDTH // 2)],
        dimension_numbers=('NWC', 'WIO', 'NWC'), feature_group_count=CONV_CH) + b_dw
    y = jax.nn.silu(layer_norm(y, ln_g, ln_b))
    return y @ w_pw


def retention_direction(q, k, v, log_gamma, strict):
    C = q.shape[3]
    idx = jnp.arange(C, dtype=jnp.float32)
    diff = idx[:, None] - idx[None, :]
    mask = (diff > 0) if strict else (diff >= 0)
    lg = log_gamma[:, None, None]
    decay = jnp.where(mask, jnp.exp(jnp.where(mask, diff, 0.0) * lg), 0.0).astype(q.dtype)
    scores = jnp.einsum('bhnqd,bhnkd->bhnqk', q, k) * decay[None, :, None]
    inner = jnp.einsum('bhnqk,bhnke->bhnqe', scores, v)
    k_dec = k * jnp.exp((C - 1 - idx)[None, :] * log_gamma[:, None]).astype(k.dtype)[None, :, None, :, None]
    u = jnp.einsum('bhnkd,bhnke->nbhde', k_dec, v)
    chunk_decay = jnp.exp(C * log_gamma).astype(u.dtype)[None, :, None, None]

    def step(state, xs):
        q_c, u_c = xs
        out = jnp.einsum('bhqd,bhde->bhqe', q_c, state)
        return chunk_decay * state + u_c, out

    state0 = jnp.zeros(u.shape[1:], u.dtype)
    _, cross = lax.scan(step, state0, (jnp.moveaxis(q, 2, 0), u))
    cross = jnp.moveaxis(cross, 0, 2) * jnp.exp((idx + 1)[None, :] * log_gamma[:, None]).astype(q.dtype)[None, :, None, :, None]
    return inner + cross


def retention_branch(q, k, v, g, cos, sin, decay_logits, gn_g, w_o):
    B, S, _ = q.shape
    nc = S // RET_CHUNK
    q = apply_rope(q.reshape(B, S, RET_HEADS, RET_DK), cos, sin)
    k = apply_rope(k.reshape(B, S, RET_HEADS, RET_DK), cos, sin) * (RET_DK ** -0.5)
    v = v.reshape(B, S, RET_HEADS, RET_DV)

    def chunked(t):
        return t.reshape(B, nc, RET_CHUNK, RET_HEADS, -1).transpose(0, 3, 1, 2, 4)

    def unchunk(t):
        return t.transpose(0, 2, 3, 1, 4).reshape(B, S, RET_HEADS, -1)

    def flip(t):
        return jnp.flip(t, axis=1)

    log_gamma = jax.nn.log_sigmoid(decay_logits.astype(jnp.float32))
    fwd = retention_direction(chunked(q), chunked(k), chunked(v), log_gamma[0], False)
    bwd = retention_direction(chunked(flip(q)), chunked(flip(k)), chunked(flip(v)), log_gamma[1], True)
    o = unchunk(fwd) + flip(unchunk(bwd))
    of = o.astype(jnp.float32)
    mu = jnp.mean(of, -1, keepdims=True)
    var = jnp.mean(jnp.square(of - mu), -1, keepdims=True)
    on = ((of - mu) * lax.rsqrt(var + EPS)).reshape(B, S, RET_HEADS * RET_DV)
    on = (on * gn_g.astype(jnp.float32)).astype(g.dtype)
    return (jax.nn.silu(g) * on) @ w_o


def setup_inputs(seed: int = 0) -> dict:
    key = jax.random.key(seed)
    ks = jax.random.split(key, 32)
    f32 = jnp.float32

    def w(k, shape, fan_in):
        return jax.random.normal(k, shape, f32) * (fan_in ** -0.5)

    def gain(k, shape):
        return 1.0 + 0.02 * jax.random.normal(k, shape, f32)

    def bias(k, shape):
        return 0.02 * jax.random.normal(k, shape, f32)

    L = DEPTH
    x = jax.random.normal(ks[0], (BATCH, SEQ, D_MODEL), f32)
    offset = jax.random.randint(ks[1], (BATCH, 1), 0, SEQ, dtype=jnp.int32)
    positions = offset + jnp.arange(SEQ, dtype=jnp.int32)[None, :]
    k_exp = 5.0 + jnp.arange(RET_HEADS, dtype=f32)
    base_logit = jnp.log(jnp.exp2(k_exp) - 1.0)
    ret_decay_logits = base_logit[None, None, :] + 0.1 * jax.random.normal(ks[2], (L, 2, RET_HEADS), f32)
    return {
        "x": x,
        "positions": positions,
        "ln_mix_pre": gain(ks[3], (L, D_MODEL)),
        "ln_mix_post": gain(ks[4], (L, D_MODEL)),
        "ln_ffn_pre": gain(ks[5], (L, D_MODEL)),
        "ln_ffn_post": gain(ks[6], (L, D_MODEL)),
        "w_in": w(ks[7], (L, D_MODEL, IN_COLS), D_MODEL),
        "mla_q_norm": gain(ks[8], (L, MLA_Q_RANK)),
        "mla_w_uq": w(ks[9], (L, MLA_Q_RANK, MLA_HEADS * (MLA_NOPE + MLA_ROPE)), MLA_Q_RANK),
        "mla_kv_norm": gain(ks[10], (L, MLA_KV_RANK)),
        "mla_w_ukv": w(ks[11], (L, MLA_KV_RANK, MLA_HEADS * (MLA_NOPE + MLA_V)), MLA_KV_RANK),
        "mla_w_o": w(ks[12], (L, MLA_HEADS * MLA_V, D_MODEL), MLA_HEADS * MLA_V),
        "conv_w_dw": w(ks[13], (L, CONV_WIDTH, CONV_CH), CONV_WIDTH),
        "conv_b_dw": bias(ks[14], (L, CONV_CH)),
        "conv_ln_g": gain(ks[15], (L, CONV_CH)),
        "conv_ln_b": bias(ks[16], (L, CONV_CH)),
        "conv_w_pw": w(ks[17], (L, CONV_CH, D_MODEL), CONV_CH),
        "ret_decay_logits": ret_decay_logits,
        "ret_gn_g": gain(ks[18], (L, RET_HEADS * RET_DV)),
        "ret_w_o": w(ks[19], (L, RET_HEADS * RET_DV, D_MODEL), RET_HEADS * RET_DV),
        "w_out": w(ks[20], (L, D_MODEL, D_MODEL), D_MODEL),
        "ffn_w_gate": w(ks[21], (L, D_MODEL, FFN_HIDDEN), D_MODEL),
        "ffn_w_up": w(ks[22], (L, D_MODEL, FFN_HIDDEN), D_MODEL),
        "ffn_w_down": w(ks[23], (L, FFN_HIDDEN, D_MODEL), FFN_HIDDEN),
    }


def reference(x, positions, ln_mix_pre, ln_mix_post, ln_ffn_pre, ln_ffn_post, w_in,
              mla_q_norm, mla_w_uq, mla_kv_norm, mla_w_ukv, mla_w_o,
              conv_w_dw, conv_b_dw, conv_ln_g, conv_ln_b, conv_w_pw,
              ret_decay_logits, ret_gn_g, ret_w_o, w_out,
              ffn_w_gate, ffn_w_up, ffn_w_down):
    B, S, _ = x.shape
    points = np.cumsum(IN_SPLITS)[:-1].tolist()
    cos_m, sin_m = rope_tables(positions, MLA_ROPE)
    cos_r, sin_r = rope_tables(positions, RET_DK)
    for l in range(DEPTH):
        h = rms_norm(x, ln_mix_pre[l])
        proj = h @ w_in[l]
        c_q, c_kv, k_pe, conv_u, r_q, r_k, r_v, r_g, gate_logits = jnp.split(proj, points, axis=-1)
        y_mla = mla_branch(c_q, c_kv, k_pe, cos_m, sin_m, mla_q_norm[l], mla_w_uq[l],
                           mla_kv_norm[l], mla_w_ukv[l], mla_w_o[l])
        y_conv = conv_branch(conv_u, conv_w_dw[l], conv_b_dw[l], conv_ln_g[l], conv_ln_b[l], conv_w_pw[l])
        y_ret = retention_branch(r_q, r_k, r_v, r_g, cos_r, sin_r, ret_decay_logits[l],
                                 ret_gn_g[l], ret_w_o[l])
        gates = jax.nn.sigmoid(gate_logits).reshape(B, S, N_BRANCH, D_MODEL)
        merged = gates[:, :, 0] * y_mla + gates[:, :, 1] * y_conv + gates[:, :, 2] * y_ret
        x = x + rms_norm(merged @ w_out[l], ln_mix_post[l])
        h = rms_norm(x, ln_ffn_pre[l])
        f = (jax.nn.silu(h @ ffn_w_gate[l]) * (h @ ffn_w_up[l])) @ ffn_w_down[l]
        x = x + rms_norm(f, ln_ffn_post[l])
    return x
```

```cpp
#include <hip/hip_runtime.h>
#include <hip/hip_cooperative_groups.h>
#include <cstdio>
#include <cstdint>
namespace cg = cooperative_groups;
namespace pg8 {
#define PG8_LAS __attribute__((address_space(3)))
typedef unsigned short bf16_t;
typedef short bf16x8 __attribute__((ext_vector_type(8)));
typedef float f32x4 __attribute__((ext_vector_type(4)));
typedef unsigned u32x4 __attribute__((ext_vector_type(4)));
constexpr int BM = 256, BK = 64, HALF = 128, HTB = HALF * BK * 2  , STAGE_BYTES = 8 * HTB, NXCD = 8, WGM = 8;

__host__ __device__ __forceinline__ int lds_byte(int r, int c) { const int st = (r >> 4) * 2 + (c >> 5), rr = r & 15, cc = c & 31, ob = rr * 64 + cc * 2; return st * 1024 + (ob ^ (((ob >> 9) & 1) << 5)); }
__host__ __device__ __forceinline__ void stage_rc(int b, int& R, int& C) { const int st = b / 1024, sb = b % 1024, swz = sb ^ (((sb >> 9) & 1) << 5); R = (st >> 1) * 16 + swz / 64; C = (st & 1) * 32 + (swz % 64) / 2; }
__host__ __device__ __forceinline__ int perm32(int rho) { const int n = rho >> 4, i = rho & 15; return 8 * (i >> 2) + 4 * n + (i & 3); }

struct Unit { int pm, pn; };
struct Gemm { const bf16_t* A; const bf16_t* Bt; int M, N, K; };

struct StaticOrder {
    int nM, nN, nwg, G, c;
    __host__ __device__ void init(int M, int N, int G_, int c_) { nM = M / BM; nN = N / BM; nwg = nM * nN; G = G_; c = c_; }
    __host__ __device__ bool next(int i, Unit& u) const {
        const long L = (long)i * G + c; if (L >= nwg) return false;
        int wgid = (int)L; { const int q = nwg / NXCD, xcd = wgid % NXCD, off = wgid / NXCD; wgid = xcd * q + off; }
        const int nig = WGM * nN, gid = wgid / nig, fm = gid * WGM, gsz = (nM - fm) < WGM ? (nM - fm) : WGM;
        u.pm = fm + ((wgid % nig) % gsz); u.pn = (wgid % nig) / gsz; return true;
    }
    __device__ __forceinline__ void a_ready(const Unit&) const {}
    __device__ __forceinline__ void done(const Unit&) const {}
};
typedef float f32x2_cv __attribute__((ext_vector_type(2)));
typedef __bf16 bf16x2_cv __attribute__((ext_vector_type(2)));
__device__ __forceinline__ unsigned cvt_pk_bf16(float lo, float hi) { const f32x2_cv v = {lo, hi}; const bf16x2_cv b = __builtin_convertvector(v, bf16x2_cv); return __builtin_bit_cast(unsigned, b); }
template <class Epi, class Sched, bool ALIGN_EPI = false, bool SP2 = false>
__device__ __forceinline__ void gemm_phase(PG8_LAS unsigned char* lds, const Gemm g, const Sched& S, const Epi& E) {
    int tid_o = (int)__builtin_amdgcn_mbcnt_hi(~0u, __builtin_amdgcn_mbcnt_lo(~0u, 0u)) | (__builtin_amdgcn_readfirstlane((int)threadIdx.x >> 6) << 6); asm volatile("" : "+v"(tid_o));
    const int tid = tid_o, wid = __builtin_amdgcn_readfirstlane(tid >> 6), lane = tid & 63, wr = wid >> 2, wc = wid & 3, fr = lane & 15, fq = lane >> 4;
    const int K = g.K, nt = K / BK;
    unsigned voffA[2], voffB[2];
#pragma unroll
    for (int i = 0; i < 2; ++i) { int R, C; stage_rc(tid * 16 + i * 8192, R, C); const int Rb = Epi::PERM ? ((R & ~31) + perm32(R & 31)) : R;
        voffA[i] = (unsigned)(R * K + C) * 2u; voffB[i] = (unsigned)(Rb * K + C) * 2u; }
    const size_t kstep = (size_t)(BK * 2);
    const size_t hstep = (size_t)HALF * K * 2;
    const size_t tstep = 2 * hstep;
    const unsigned ldsw = (unsigned)wid * 1024u;
    const int aoff = lds_byte(wr * 64 + fr, fq * 8), boff = lds_byte(wc * 32 + fr, fq * 8);
#define PG8_SA(b, h) (((b) * 2 + (h)) * HTB)
#define PG8_SB(b, h) ((4 + (b) * 2 + (h)) * HTB)
#define PG8_STAGE(bufoff, gbase, voff) do { _Pragma("unroll") for (int _i = 0; _i < 2; ++_i) \
        __builtin_amdgcn_global_load_lds((const unsigned*)((const char*)(gbase) + (voff)[_i]), (PG8_LAS unsigned*)(lds + (bufoff) + ldsw + _i * 8192), 16, 0, 0); } while (0)
#define PG8_LDA(dst, b, h) do { _Pragma("unroll") for (int m = 0; m < 4; ++m) _Pragma("unroll") for (int k = 0; k < 2; ++k) dst[m][k] = *(const PG8_LAS bf16x8*)(lds + PG8_SA(b, h) + aoff + m * 2048 + k * 1024); } while (0)
#define PG8_LDB(dst, b, h) do { _Pragma("unroll") for (int n = 0; n < 2; ++n) _Pragma("unroll") for (int k = 0; k < 2; ++k) dst[n][k] = *(const PG8_LAS bf16x8*)(lds + PG8_SB(b, h) + boff + n * 2048 + k * 1024); } while (0)
#define PG8_MMA(ai, bj, At, Bt) do { __builtin_amdgcn_s_setprio(1); _Pragma("unroll") for (int m = 0; m < 4; ++m) _Pragma("unroll") for (int n = 0; n < 2; ++n) _Pragma("unroll") for (int k = 0; k < 2; ++k) \
        acc[ai][bj][m][n] = __builtin_amdgcn_mfma_f32_16x16x32_bf16(Bt[n][k], At[m][k], acc[ai][bj][m][n], 0, 0, 0); __builtin_amdgcn_s_setprio(0); } while (0)
#define PG8_WAIT_V(n) asm volatile("s_waitcnt vmcnt(" #n ")" ::: "memory")
#define PG8_WAIT_L(n) asm volatile("s_waitcnt lgkmcnt(" #n ")" ::: "memory")
#define PG8_BAR __builtin_amdgcn_s_barrier()
#define PG8_SCHED __builtin_amdgcn_sched_barrier(0)
    Unit cur, nxt; int ui = 0;
    if (!S.next(0, cur)) return;
    f32x4 acc[2][2][4][2];
#pragma unroll
    for (int a = 0; a < 2; ++a)
#pragma unroll
        for (int b = 0; b < 2; ++b)
#pragma unroll
            for (int m = 0; m < 4; ++m)
#pragma unroll
                for (int n = 0; n < 2; ++n) acc[a][b][m][n] = (f32x4){0.f, 0.f, 0.f, 0.f};
    bf16x8 At[4][2], B0[2][2], B1[2][2];
    const char* cA = (const char*)g.A + (size_t)cur.pm * tstep; const char* cB = (const char*)g.Bt + (size_t)cur.pn * tstep;
    S.a_ready(cur);
    if constexpr (SP2) {
        PG8_STAGE(PG8_SB(0, 0), cB, voffB); PG8_STAGE(PG8_SB(0, 1), cB + hstep, voffB); PG8_STAGE(PG8_SA(0, 0), cA, voffA); PG8_STAGE(PG8_SA(0, 1), cA + hstep, voffA);
        if (wr == 1) PG8_BAR;
        PG8_WAIT_V(2); PG8_BAR;
        PG8_STAGE(PG8_SB(1, 0), cB + kstep, voffB); PG8_STAGE(PG8_SA(1, 0), cA + kstep, voffA); PG8_STAGE(PG8_SB(1, 1), cB + hstep + kstep, voffB);
        PG8_WAIT_V(6); PG8_BAR;
    } else {
        PG8_STAGE(PG8_SB(0, 0), cB, voffB); PG8_STAGE(PG8_SA(0, 0), cA, voffA); PG8_STAGE(PG8_SB(0, 1), cB + hstep, voffB); PG8_STAGE(PG8_SA(0, 1), cA + hstep, voffA);
        if (wr == 1) PG8_BAR;
        PG8_WAIT_V(4); PG8_BAR;
        PG8_STAGE(PG8_SB(1, 0), cB + kstep, voffB); PG8_STAGE(PG8_SA(1, 0), cA + kstep, voffA); PG8_STAGE(PG8_SB(1, 1), cB + hstep + kstep, voffB);
        PG8_WAIT_V(6); PG8_BAR;
    }
    for (;;) {
        const bool has_next = S.next(ui + 1, nxt);
        const char* nA = has_next ? (const char*)g.A + (size_t)nxt.pm * tstep : cA; const char* nB = has_next ? (const char*)g.Bt + (size_t)nxt.pn * tstep : cB;
        for (int t = 0; t < nt; t += 2) {
            const bool last = (t == nt - 2);
            const char* a1 = cA + (size_t)(t + 1) * kstep;
            const char* a2 = last ? nA : cA + (size_t)(t + 2) * kstep; const char* b2 = last ? nB : cB + (size_t)(t + 2) * kstep;
            const char* a3 = a2 + kstep; const char* b3 = b2 + kstep;
            if (last && has_next) S.a_ready(nxt);
            if constexpr (SP2) {
            PG8_LDB(B0, 0, 0); PG8_LDB(B1, 0, 1); PG8_SCHED; PG8_LDA(At, 0, 0); PG8_STAGE(PG8_SA(1, 1), a1 + hstep, voffA);
            PG8_WAIT_V(8); PG8_WAIT_L(0); PG8_BAR; PG8_MMA(0, 0, At, B0); PG8_MMA(0, 1, At, B1); PG8_BAR; PG8_SCHED;
            PG8_LDA(At, 0, 1); PG8_STAGE(PG8_SB(0, 0), b2, voffB); PG8_STAGE(PG8_SB(0, 1), b2 + hstep, voffB); PG8_STAGE(PG8_SA(0, 0), a2, voffA);
            PG8_WAIT_V(8); PG8_WAIT_L(0); PG8_BAR; PG8_MMA(1, 0, At, B0); PG8_MMA(1, 1, At, B1); PG8_BAR; PG8_SCHED;
            PG8_LDB(B0, 1, 0); PG8_LDB(B1, 1, 1); PG8_SCHED; PG8_LDA(At, 1, 0); PG8_STAGE(PG8_SA(0, 1), a2 + hstep, voffA);
            PG8_WAIT_V(8); PG8_WAIT_L(0); PG8_BAR; PG8_MMA(0, 0, At, B0); PG8_MMA(0, 1, At, B1); PG8_BAR; PG8_SCHED;
            PG8_LDA(At, 1, 1); PG8_STAGE(PG8_SB(1, 0), b3, voffB); PG8_STAGE(PG8_SB(1, 1), b3 + hstep, voffB); PG8_STAGE(PG8_SA(1, 0), a3, voffA);
            PG8_WAIT_V(8); PG8_WAIT_L(0); PG8_BAR; PG8_MMA(1, 0, At, B0); PG8_MMA(1, 1, At, B1); PG8_BAR; PG8_SCHED;
            } else {
            PG8_LDB(B0, 0, 0); PG8_SCHED; PG8_LDA(At, 0, 0); PG8_STAGE(PG8_SA(1, 1), a1 + hstep, voffA);
            PG8_WAIT_L(8); PG8_BAR; PG8_WAIT_L(0); PG8_MMA(0, 0, At, B0); PG8_BAR; PG8_SCHED;
            PG8_LDB(B1, 0, 1); PG8_STAGE(PG8_SB(0, 0), b2, voffB);
            PG8_BAR; PG8_WAIT_L(0); PG8_MMA(0, 1, At, B1); PG8_BAR;
            PG8_LDA(At, 0, 1); PG8_STAGE(PG8_SA(0, 0), a2, voffA);
            PG8_BAR; PG8_WAIT_L(0); PG8_MMA(1, 0, At, B0); PG8_BAR; PG8_SCHED;
            PG8_STAGE(PG8_SB(0, 1), b2 + hstep, voffB);
            PG8_WAIT_V(6); PG8_BAR; PG8_MMA(1, 1, At, B1); PG8_BAR;
            PG8_LDB(B0, 1, 0); PG8_SCHED; PG8_LDA(At, 1, 0); PG8_STAGE(PG8_SA(0, 1), a2 + hstep, voffA);
            PG8_WAIT_L(8); PG8_BAR; PG8_WAIT_L(0); PG8_MMA(0, 0, At, B0); PG8_BAR; PG8_SCHED;
            PG8_LDB(B1, 1, 1); PG8_STAGE(PG8_SB(1, 0), b3, voffB);
            PG8_BAR; PG8_WAIT_L(0); PG8_MMA(0, 1, At, B1); PG8_BAR;
            PG8_LDA(At, 1, 1); PG8_STAGE(PG8_SA(1, 0), a3, voffA);
            PG8_BAR; PG8_WAIT_L(0); PG8_MMA(1, 0, At, B0); PG8_BAR; PG8_SCHED;
            PG8_STAGE(PG8_SB(1, 1), b3 + hstep, voffB);
            PG8_WAIT_V(6); PG8_BAR; PG8_MMA(1, 1, At, B1); PG8_BAR;
            }
        }
        if constexpr (ALIGN_EPI) { if (wr == 0) PG8_BAR; }
        if constexpr (!Epi::AFTER_DRAIN) { E(acc, cur, wr, wc, fr, fq); S.done(cur); }
        if (!has_next) break;
#pragma unroll
        for (int a = 0; a < 2; ++a)
#pragma unroll
            for (int b = 0; b < 2; ++b)
#pragma unroll
                for (int m = 0; m < 4; ++m)
#pragma unroll
                    for (int n = 0; n < 2; ++n) acc[a][b][m][n] = (f32x4){0.f, 0.f, 0.f, 0.f};
        cur = nxt; cA = nA; cB = nB; ++ui;
        if constexpr (ALIGN_EPI) { if (wr == 1) PG8_BAR; }
    }
    PG8_WAIT_V(0);
    if constexpr (!ALIGN_EPI) { if (wr == 0) PG8_BAR; }
    PG8_BAR;
    if constexpr (Epi::AFTER_DRAIN) { E.fused(acc, cur, wr, wc, fr, fq, lds, wid, lane); S.done(cur); }
#undef PG8_SA
#undef PG8_SB
#undef PG8_STAGE
#undef PG8_LDA
#undef PG8_LDB
#undef PG8_MMA
#undef PG8_WAIT_V
#undef PG8_WAIT_L
#undef PG8_BAR
#undef PG8_SCHED
}
}

using pg8::bf16_t; using pg8::bf16x8; using pg8::f32x4; using pg8::u32x4; using pg8::Unit; using pg8::Gemm; using pg8::StaticOrder; using pg8::cvt_pk_bf16;
#define LAS __attribute__((address_space(3)))
typedef float f32x16 __attribute__((ext_vector_type(16)));
typedef unsigned u32x2 __attribute__((ext_vector_type(2)));

constexpr int DM = 1024, NB = 16, SEQ = 4096, DEPTH = 2, MTOT = NB * SEQ;
constexpr int NG = 2, GB = NB / NG, MG = GB * SEQ;
constexpr int IN_COLS = 7584, NIN = 7680, NQKV = 1792, KQKV = 384, FFH = 2816, NGU = 2 * FFH;
constexpr float EPS = 1e-6f;
constexpr float QSCALE = 0.10206207261596577f * 1.4426950408889634f;
constexpr float RKSCALE = 0.08838834764831845f;

constexpr size_t al256(size_t x) { return (x + 255) & ~(size_t)255; }
constexpr size_t WS_CTL = 0, CTL_BYTES = 32768;
constexpr size_t SZ_WIN = (size_t)NIN * DM * 2, SZ_WQKV = (size_t)NQKV * KQKV * 2, SZ_WMO = (size_t)DM * 512 * 2, SZ_WPW = (size_t)DM * 512 * 2,
                 SZ_WRO = (size_t)DM * DM * 2, SZ_WOUT = (size_t)DM * DM * 2, SZ_WGU = (size_t)NGU * DM * 2, SZ_WDN = (size_t)DM * FFH * 2;
constexpr size_t OFF_WIN = 0, OFF_WQKV = OFF_WIN + SZ_WIN, OFF_WMO = OFF_WQKV + al256(SZ_WQKV), OFF_WPW = OFF_WMO + SZ_WMO, OFF_WRO = OFF_WPW + SZ_WPW,
                 OFF_WOUT = OFF_WRO + SZ_WRO, OFF_WGU = OFF_WOUT + SZ_WOUT, OFF_WDN = OFF_WGU + SZ_WGU, WL_BYTES = al256(OFF_WDN + SZ_WDN);
constexpr size_t WS_W = 32768;
constexpr size_t WS_COSR = WS_W + DEPTH * WL_BYTES, WS_SINR = WS_COSR + (size_t)MTOT * 64 * 4, WS_COSM = WS_SINR + (size_t)MTOT * 64 * 4, WS_SINM = WS_COSM + (size_t)MTOT * 16 * 4;
constexpr size_t WS_XB = WS_SINM + (size_t)MTOT * 16 * 4;
constexpr size_t WS_CQKV = WS_XB + (size_t)MG * 1024 * 2;
constexpr size_t WS_KPE = WS_CQKV + (size_t)MG * 384 * 2;
constexpr size_t WS_CONVA = WS_KPE + (size_t)MG * 32 * 2;
constexpr size_t WS_RQ = WS_CONVA + (size_t)MG * 512 * 2;
constexpr size_t WS_RK = WS_RQ + (size_t)MG * 512 * 2;
constexpr size_t WS_RV = WS_RK + (size_t)MG * 512 * 2;
constexpr size_t WS_RG = WS_RV + (size_t)MG * 1024 * 2;
constexpr size_t WS_GATES = WS_RG + (size_t)MG * 1024 * 2;
constexpr size_t WS_Q = WS_GATES + (size_t)MG * 3072 * 2;
constexpr size_t WS_KN = WS_Q + (size_t)MG * 768 * 2;
constexpr size_t WS_VT = WS_KN + (size_t)MG * 512 * 2;
constexpr size_t WS_OMLA = WS_VT + (size_t)MG * 512 * 2;
constexpr size_t WS_CONVY = WS_OMLA + (size_t)MG * 512 * 2;
constexpr size_t WS_RETF = WS_CONVY + (size_t)MG * 512 * 2;
constexpr size_t WS_RETB = WS_RETF + (size_t)MG * 1024 * 2;
constexpr size_t WS_SSQ = WS_RETB + (size_t)MG * 1024 * 2;
constexpr size_t WS_F2 = WS_SSQ + (size_t)MG * 8 * 4;
constexpr size_t WS_END = WS_F2 + (size_t)MG * 1024 * 2;
static_assert(WS_END <= (size_t)1 << 30, "workspace map must fit 1 GiB");

constexpr int LDS_BYTES = 147456, LDS_MISC = 131072;

struct Params { const float* in[24]; float* out; unsigned char* ws; };
typedef const __attribute__((address_space(4))) unsigned char* kptr_t;
#define PIN(i) (*(const float* const __attribute__((address_space(4)))*)(kp + 8 * (i)))
#define POUT (*(float* const __attribute__((address_space(4)))*)(kp + 192))
#define PWS (*(unsigned char* const __attribute__((address_space(4)))*)(kp + 200))

__device__ __forceinline__ int otid() { int t = (int)__builtin_amdgcn_mbcnt_hi(~0u, __builtin_amdgcn_mbcnt_lo(~0u, 0u)) | (__builtin_amdgcn_readfirstlane((int)threadIdx.x >> 6) << 6); asm volatile("" : "+v"(t)); return t; }
__device__ __forceinline__ float bf_lo(unsigned w) { return __builtin_bit_cast(float, w << 16); }
__device__ __forceinline__ float bf_hi(unsigned w) { return __builtin_bit_cast(float, w & 0xffff0000u); }
__device__ __forceinline__ float bf2f(unsigned short h) { return __builtin_bit_cast(float, (unsigned)h << 16); }
__device__ __forceinline__ unsigned short f2bf(float f) { return (unsigned short)(cvt_pk_bf16(f, 0.f) & 0xffffu); }
__device__ __forceinline__ u32x4 pack8(f32x4 a, f32x4 b) { u32x4 w; w.x = cvt_pk_bf16(a[0], a[1]); w.y = cvt_pk_bf16(a[2], a[3]); w.z = cvt_pk_bf16(b[0], b[1]); w.w = cvt_pk_bf16(b[2], b[3]); return w; }
__device__ __forceinline__ void store8(bf16_t* p, f32x4 a, f32x4 b) { *(u32x4*)p = pack8(a, b); }
__device__ __forceinline__ void unpack8(u32x4 w, f32x4& a, f32x4& b) { a = (f32x4){bf_lo(w.x), bf_hi(w.x), bf_lo(w.y), bf_hi(w.y)}; b = (f32x4){bf_lo(w.z), bf_hi(w.z), bf_lo(w.w), bf_hi(w.w)}; }
__device__ __forceinline__ float sigm(float x) { return __builtin_amdgcn_rcpf(1.f + __builtin_amdgcn_exp2f(x * -1.4426950408889634f)); }
__device__ __forceinline__ f32x4 sigm4(f32x4 x) {
    const f32x4 t = x * -1.4426950408889634f;
    const f32x4 e = (f32x4){__builtin_amdgcn_exp2f(t[0]), __builtin_amdgcn_exp2f(t[1]), __builtin_amdgcn_exp2f(t[2]), __builtin_amdgcn_exp2f(t[3])};
    const f32x4 d = e + 1.0f;
    return (f32x4){__builtin_amdgcn_rcpf(d[0]), __builtin_amdgcn_rcpf(d[1]), __builtin_amdgcn_rcpf(d[2]), __builtin_amdgcn_rcpf(d[3])};
}
__device__ __forceinline__ float shx(float v, int o, int lane) { (void)lane; return __shfl_xor(v, o); }
__device__ __forceinline__ float wave_sum(float v, int lane) {
#pragma unroll
    for (int o = 1; o < 64; o <<= 1) v += shx(v, o, lane);
    return v;
}
__device__ __forceinline__ float dot4(f32x4 a) { return (a[0] * a[0] + a[1] * a[1]) + (a[2] * a[2] + a[3] * a[3]); }
__device__ __forceinline__ void rope8(f32x4& a, f32x4& b, f32x4 c, f32x4 s) {
    f32x4 ra, rb;
    ra[0] = a[0] * c[0] - a[1] * s[0]; ra[1] = a[1] * c[0] + a[0] * s[0];
    ra[2] = a[2] * c[1] - a[3] * s[1]; ra[3] = a[3] * c[1] + a[2] * s[1];
    rb[0] = b[0] * c[2] - b[1] * s[2]; rb[1] = b[1] * c[2] + b[0] * s[2];
    rb[2] = b[2] * c[3] - b[3] * s[3]; rb[3] = b[3] * c[3] + b[2] * s[3];
    a = ra; b = rb;
}

#define FOR_ROWS(...) _Pragma("unroll") for (int ai = 0; ai < 2; ++ai) _Pragma("unroll") for (int m = 0; m < 4; ++m) { \
    const int row = u.pm * 256 + ai * 128 + wr * 64 + m * 16 + fr; \
    f32x4 a0 = acc[ai][0][m][0], a1 = acc[ai][0][m][1], b0 = acc[ai][1][m][0], b1 = acc[ai][1][m][1]; __VA_ARGS__ __builtin_amdgcn_sched_barrier(0); }
struct EpiBase { static constexpr bool PERM = true, AFTER_DRAIN = false; };

struct EpiIn : EpiBase {
    bf16_t *cqkv, *kpe, *conva, *rq, *rk, *rv, *rg, *gates; float* ssq; const float *cosr, *sinr, *cosm, *sinm;
    __device__ __forceinline__ void operator()(const f32x4 (&acc)[2][2][4][2], const Unit& u, int wr, int wc, int fr_, int fq_) const {
        int fr = fr_, fq = fq_; asm volatile("" : "+v"(fr), "+v"(fq));
        const int pn = u.pn, cl = wc * 32 + 8 * fq;
        if (pn == 0) {
            FOR_ROWS(
                store8(cqkv + (size_t)row * 384 + cl, a0, a1); store8(cqkv + (size_t)row * 384 + 128 + cl, b0, b1);
                float s = (dot4(a0) + dot4(a1)) + (dot4(b0) + dot4(b1)); s += shx(s, 16, fr + 16 * fq); s += shx(s, 32, fr + 16 * fq);
                if (fq == 0) ssq[row * 8 + wc] = s;
            )
        } else if (pn == 1) {
            FOR_ROWS(
                store8(cqkv + (size_t)row * 384 + 256 + cl, a0, a1);
                float s = dot4(a0) + dot4(a1); s += shx(s, 16, fr + 16 * fq); s += shx(s, 32, fr + 16 * fq);
                if (fq == 0) ssq[row * 8 + 4 + wc] = s;
                if (wc == 0) { const f32x4 c = *(const f32x4*)(cosm + (size_t)row * 16 + 4 * fq), sn = *(const f32x4*)(sinm + (size_t)row * 16 + 4 * fq);
                    rope8(b0, b1, c, sn); store8(kpe + (size_t)row * 32 + cl, b0, b1); }
            )
        } else if (pn < 6) {
            const int t = pn - 2;
            FOR_ROWS( store8(conva + (size_t)row * 512 + t * 128 + cl, a0 * sigm4(b0), a1 * sigm4(b1)); )
        } else if (pn < 10) {
            const bool isk = pn >= 8; bf16_t* dst = isk ? rk : rq; const int h0 = (isk ? pn - 8 : pn - 6) * 2; const float sc = isk ? RKSCALE : 1.f;
            FOR_ROWS(
                const f32x4 c = *(const f32x4*)(cosr + (size_t)row * 64 + (cl >> 1)), sn = *(const f32x4*)(sinr + (size_t)row * 64 + (cl >> 1));
                rope8(a0, a1, c, sn); rope8(b0, b1, c, sn);
                store8(dst + (size_t)row * 512 + h0 * 128 + cl, a0 * sc, a1 * sc); store8(dst + (size_t)row * 512 + (h0 + 1) * 128 + cl, b0 * sc, b1 * sc);
            )
        } else if (pn < 14) {
            const int t = pn - 10;
            FOR_ROWS( store8(rv + (size_t)row * 1024 + t * 256 + cl, a0, a1); store8(rv + (size_t)row * 1024 + t * 256 + 128 + cl, b0, b1); )
        } else if (pn < 18) {
            const int t = pn - 14;
            FOR_ROWS( store8(rg + (size_t)row * 1024 + t * 256 + cl, a0 * sigm4(a0), a1 * sigm4(a1)); store8(rg + (size_t)row * 1024 + t * 256 + 128 + cl, b0 * sigm4(b0), b1 * sigm4(b1)); )
        } else {
            const int t = pn - 18;
            FOR_ROWS( store8(gates + (size_t)row * 3072 + t * 256 + cl, sigm4(a0), sigm4(a1)); store8(gates + (size_t)row * 3072 + t * 256 + 128 + cl, sigm4(b0), sigm4(b1)); )
        }
    }
};

__device__ __forceinline__ float ssq4(const float* p) { const f32x4 v = *(const f32x4*)p; return (v[0] + v[1]) + (v[2] + v[3]); }
struct EpiQKV : EpiBase {
    bf16_t *q, *kn, *vt; const float* ssq; const float *cosm, *sinm;
    __device__ __forceinline__ void operator()(const f32x4 (&acc)[2][2][4][2], const Unit& u, int wr, int wc, int fr_, int fq_) const {
        int fr = fr_, fq = fq_; asm volatile("" : "+v"(fr), "+v"(fq));
        const int pn = u.pn, cl = wc * 32 + 8 * fq;
        if (pn < 2) {
            FOR_ROWS( const float r = rsqrtf(ssq4(ssq + row * 8) * (1.f / 256.f) + EPS) * QSCALE;
                store8(q + (size_t)row * 768 + pn * 256 + cl, a0 * r, a1 * r); store8(q + (size_t)row * 768 + pn * 256 + 128 + cl, b0 * r, b1 * r); )
        } else if (pn == 2) {
            FOR_ROWS( const float r = rsqrtf(ssq4(ssq + row * 8) * (1.f / 256.f) + EPS) * QSCALE;
                const f32x4 c = *(const f32x4*)(cosm + (size_t)row * 16 + 4 * fq), sn = *(const f32x4*)(sinm + (size_t)row * 16 + 4 * fq);
                rope8(a0, a1, c, sn); rope8(b0, b1, c, sn);
                store8(q + (size_t)row * 768 + 512 + cl, a0 * r, a1 * r); store8(q + (size_t)row * 768 + 512 + 128 + cl, b0 * r, b1 * r); )
        } else {
            const int hA = (pn - 3) * 2;
            if (wc < 2) {
                FOR_ROWS( const float r = rsqrtf(ssq4(ssq + row * 8 + 4) * (1.f / 128.f) + EPS);
                    store8(kn + (size_t)row * 512 + hA * 64 + cl, a0 * r, a1 * r); store8(kn + (size_t)row * 512 + (hA + 1) * 64 + cl, b0 * r, b1 * r); )
            } else {
                const int d0 = cl - 64;
                FOR_ROWS( const float r = rsqrtf(ssq4(ssq + row * 8 + 4) * (1.f / 128.f) + EPS);
                    const int bl = row >> 12, s = row & 4095;
                    bf16_t* pa = vt + ((((size_t)bl * 64 + (s >> 6)) * 8 + (d0 >> 3)) * 8 + hA) * 512 + (s & 63);
                    _Pragma("unroll") for (int t = 0; t < 4; ++t) { pa[t * 64] = f2bf(a0[t] * r); pa[(t + 4) * 64] = f2bf(a1[t] * r);
                                                  pa[512 + t * 64] = f2bf(b0[t] * r); pa[512 + (t + 4) * 64] = f2bf(b1[t] * r); } )
            }
        }
    }
};

template <int MODE> struct EpiMerge : EpiBase {
    bf16_t* merged; const bf16_t* gates; int gi;
    __device__ __forceinline__ void operator()(const f32x4 (&acc)[2][2][4][2], const Unit& u, int wr, int wc, int fr_, int fq_) const {
        int fr = fr_, fq = fq_; asm volatile("" : "+v"(fr), "+v"(fq));
        const int cl = wc * 32 + 8 * fq, col = u.pn * 256 + cl;
        FOR_ROWS(
            f32x4 g0, g1, g2, g3; unpack8(*(const u32x4*)(gates + (size_t)row * 3072 + gi * 1024 + col), g0, g1); unpack8(*(const u32x4*)(gates + (size_t)row * 3072 + gi * 1024 + col + 128), g2, g3);
            a0 = a0 * g0; a1 = a1 * g1; b0 = b0 * g2; b1 = b1 * g3;
            if (MODE == 1) { f32x4 p0, p1, p2, p3; unpack8(*(const u32x4*)(merged + (size_t)row * 1024 + col), p0, p1); unpack8(*(const u32x4*)(merged + (size_t)row * 1024 + col + 128), p2, p3);
                a0 = a0 + p0; a1 = a1 + p1; b0 = b0 + p2; b1 = b1 + p3; }
            store8(merged + (size_t)row * 1024 + col, a0, a1); store8(merged + (size_t)row * 1024 + col + 128, b0, b1);
        )
    }
};

struct EpiPlain : EpiBase {
    bf16_t* o; int ldc;
    __device__ __forceinline__ void operator()(const f32x4 (&acc)[2][2][4][2], const Unit& u, int wr, int wc, int fr_, int fq_) const {
        int fr = fr_, fq = fq_; asm volatile("" : "+v"(fr), "+v"(fq));
        const int col = u.pn * 256 + wc * 32 + 8 * fq;
        FOR_ROWS( store8(o + (size_t)row * ldc + col, a0, a1); store8(o + (size_t)row * ldc + col + 128, b0, b1); )
    }
};

struct EpiSwiGLU : EpiBase {
    bf16_t* hid;
    __device__ __forceinline__ void operator()(const f32x4 (&acc)[2][2][4][2], const Unit& u, int wr, int wc, int fr_, int fq_) const {
        int fr = fr_, fq = fq_; asm volatile("" : "+v"(fr), "+v"(fq));
        const int col = u.pn * 128 + wc * 32 + 8 * fq;
        FOR_ROWS( store8(hid + (size_t)row * FFH + col, a0 * sigm4(a0) * b0, a1 * sigm4(a1) * b1); )
    }
};

__device__ __forceinline__ int srcmap_in(int n) {
    if (n < 384) return n;
    if (n < 416) { const int p = n - 384; return 384 + (p >> 1) + 16 * (p & 1); }
    if (n < 512) return -1;
    if (n < 1536) { const int t = (n - 512) >> 8, j = (n - 512) & 255; return j < 128 ? 416 + t * 128 + j : 416 + 512 + t * 128 + (j - 128); }
    if (n < 2560) { const int isk = n >= 2048, nn = (n - 1536) & 511, hh = nn >> 7, p = nn & 127; return (isk ? 1952 : 1440) + hh * 128 + (p >> 1) + 64 * (p & 1); }
    if (n < 3584) return 2464 + (n - 2560);
    if (n < 4608) return 3488 + (n - 3584);
    return 4512 + (n - 4608);
}
template <class F> __device__ __forceinline__ void transpose_w(F elem, int N, int K, bf16_t* WT, LAS float* scr, int gw, int nw, int lane) {
    const int nblk = N / 32, total = nblk * (K / 64);
    for (int item = gw; item < total; item += nw) {
        const int kb = item / nblk, nb = item % nblk, k0 = 64 * kb, n0 = 32 * nb;
        float ev[32];
#pragma unroll
        for (int i = 0; i < 32; ++i) ev[i] = elem(n0 + (lane & 31), k0 + 2 * i + (lane >> 5));
#pragma unroll
        for (int i = 0; i < 32; ++i) scr[(2 * i + (lane >> 5)) * 33 + (lane & 31)] = ev[i];
        asm volatile("s_waitcnt lgkmcnt(0)" ::: "memory");
        const int c = lane & 7;
#pragma unroll
        for (int j = 0; j < 4; ++j) { const int n = (lane >> 3) + 8 * j; const LAS float* s = scr + (8 * c) * 33 + n;
            u32x4 o; o.x = cvt_pk_bf16(s[0 * 33], s[1 * 33]); o.y = cvt_pk_bf16(s[2 * 33], s[3 * 33]); o.z = cvt_pk_bf16(s[4 * 33], s[5 * 33]); o.w = cvt_pk_bf16(s[6 * 33], s[7 * 33]);
            *(u32x4*)(WT + (size_t)(n0 + n) * K + k0 + 8 * c) = o; }
        asm volatile("s_waitcnt lgkmcnt(0)" ::: "memory");
    }
}

__device__ __forceinline__ void prologue(kptr_t kp, LAS unsigned char* lds, int gw, int nw, int wid, int lane, int l_lo = 0, int l_hi = DEPTH, bool tables = true) {
    unsigned char* const ws_ = PWS;
    LAS float* scr = (LAS float*)(lds + wid * (64 * 33 * 4));
    for (int l = l_lo; l < l_hi; ++l) {
        unsigned char* wl = ws_ + WS_W + (size_t)l * WL_BYTES;
        const float* w_in = PIN(6) + (size_t)l * DM * IN_COLS;
        transpose_w([=](int n, int k) { const int s = srcmap_in(n); return s < 0 ? 0.f : w_in[(size_t)k * IN_COLS + s]; }, NIN, DM, (bf16_t*)(wl + OFF_WIN), scr, gw, nw, lane);
        const float* qn = PIN(7) + l * 256; const float* wuq = PIN(8) + (size_t)l * 256 * 768; const float* kvn = PIN(9) + l * 128; const float* wukv = PIN(10) + (size_t)l * 128 * 1024;
        transpose_w([=](int n, int k) {
            if (n < 768) { if (k >= 256) return 0.f;
                int s; if (n < 512) s = (n >> 6) * 96 + (n & 63); else { const int hh = (n - 512) >> 5, p = (n - 512) & 31; s = hh * 96 + 64 + (p >> 1) + 16 * (p & 1); }
                return wuq[(size_t)k * 768 + s] * qn[k]; }
            if (k < 256) return 0.f;
            return wukv[(size_t)(k - 256) * 1024 + (n - 768)] * kvn[k - 256]; }, NQKV, KQKV, (bf16_t*)(wl + OFF_WQKV), scr, (gw + 300) % nw, nw, lane);
        const float* wmo = PIN(11) + (size_t)l * 512 * DM;
        transpose_w([=](int n, int k) { return wmo[(size_t)k * DM + n]; }, DM, 512, (bf16_t*)(wl + OFF_WMO), scr, (gw + 700) % nw, nw, lane);
        const float* wpw = PIN(16) + (size_t)l * 512 * DM;
        transpose_w([=](int n, int k) { return wpw[(size_t)k * DM + n]; }, DM, 512, (bf16_t*)(wl + OFF_WPW), scr, (gw + 1000) % nw, nw, lane);
        const float* wro = PIN(19) + (size_t)l * DM * DM;
        transpose_w([=](int n, int k) { return wro[(size_t)k * DM + n]; }, DM, DM, (bf16_t*)(wl + OFF_WRO), scr, (gw + 1300) % nw, nw, lane);
        const float* wout = PIN(20) + (size_t)l * DM * DM;
        transpose_w([=](int n, int k) { return wout[(size_t)k * DM + n]; }, DM, DM, (bf16_t*)(wl + OFF_WOUT), scr, (gw + 1800) % nw, nw, lane);
        const float* wg = PIN(21) + (size_t)l * DM * FFH; const float* wu = PIN(22) + (size_t)l * DM * FFH;
        transpose_w([=](int n, int k) { const int t = n >> 8, j = n & 255; return j < 128 ? wg[(size_t)k * FFH + t * 128 + j] : wu[(size_t)k * FFH + t * 128 + j - 128]; }, NGU, DM, (bf16_t*)(wl + OFF_WGU), scr, gw, nw, lane);
        const float* wd = PIN(23) + (size_t)l * FFH * DM;
        transpose_w([=](int n, int k) { return wd[(size_t)k * DM + n]; }, DM, FFH, (bf16_t*)(wl + OFF_WDN), scr, (gw + 500) % nw, nw, lane);
    }
    if (!tables) return;
    const int* pos = (const int*)PIN(1);
    float* cosr = (float*)(ws_ + WS_COSR); float* sinr = (float*)(ws_ + WS_SINR); float* cosm = (float*)(ws_ + WS_COSM); float* sinm = (float*)(ws_ + WS_SINM);
    const float invr = exp2f(-(float)lane * (13.287712379549449f / 64.f));
    const float invm = exp2f(-(float)(lane & 15) * (13.287712379549449f / 16.f));
    for (int t = gw; t < MTOT; t += nw) {
        const float pf = (float)pos[t];
        { const float ang = pf * invr; double r = (double)ang * 0.15915494309189535; r -= floor(r); const float rf = (float)r;
          cosr[(size_t)t * 64 + lane] = __builtin_amdgcn_cosf(rf); sinr[(size_t)t * 64 + lane] = __builtin_amdgcn_sinf(rf); }
        if (lane < 16) { const float ang = pf * invm; double r = (double)ang * 0.15915494309189535; r -= floor(r); const float rf = (float)r;
          cosm[(size_t)t * 16 + lane] = __builtin_amdgcn_cosf(rf); sinm[(size_t)t * 16 + lane] = __builtin_amdgcn_sinf(rf); }
    }
}

template <bool HASF, int NR, bool HASF2 = false>
__device__ __forceinline__ void rowpass_x_t(const float* xin, const bf16_t* f, const float* gpost, float* xout, const float* gnext, bf16_t* xb, int rows, int gw, int nw, int lane, const bf16_t* f2 = nullptr, const float* gpost2 = nullptr) {
    for (int row0 = gw; row0 < rows; row0 += NR * nw) {
        f32x4 v[NR][4]; u32x2 fw[NR][4]; u32x2 fw2[NR][4];
#pragma unroll
        for (int u = 0; u < NR; ++u)
#pragma unroll
            for (int j = 0; j < 4; ++j) { v[u][j] = __builtin_nontemporal_load((const f32x4*)(xin + (size_t)(row0 + u * nw) * DM + 4 * lane + 256 * j));
                if (HASF) fw[u][j] = __builtin_nontemporal_load((const u32x2*)(f + (size_t)(row0 + u * nw) * DM + 4 * lane + 256 * j));
                if (HASF2) fw2[u][j] = __builtin_nontemporal_load((const u32x2*)(f2 + (size_t)(row0 + u * nw) * DM + 4 * lane + 256 * j)); }
#pragma unroll
        for (int u = 0; u < NR; ++u) {
            const int row = row0 + u * nw;
            if (HASF) {
                f32x4 fv[4]; float ss = 0.f;
#pragma unroll
                for (int j = 0; j < 4; ++j) { const u32x2 w = fw[u][j]; fv[j] = (f32x4){bf_lo(w.x), bf_hi(w.x), bf_lo(w.y), bf_hi(w.y)}; ss += dot4(fv[j]); }
                const float r = rsqrtf(wave_sum(ss, lane) * (1.f / DM) + EPS);
#pragma unroll
                for (int j = 0; j < 4; ++j) { const f32x4 g = *(const f32x4*)(gpost + 4 * lane + 256 * j); v[u][j] = v[u][j] + fv[j] * r * g; }
            }
            if (HASF2) {
                f32x4 fv[4]; float ss = 0.f;
#pragma unroll
                for (int j = 0; j < 4; ++j) { const u32x2 w = fw2[u][j]; fv[j] = (f32x4){bf_lo(w.x), bf_hi(w.x), bf_lo(w.y), bf_hi(w.y)}; ss += dot4(fv[j]); }
                const float r = rsqrtf(wave_sum(ss, lane) * (1.f / DM) + EPS);
#pragma unroll
                for (int j = 0; j < 4; ++j) { const f32x4 g = *(const f32x4*)(gpost2 + 4 * lane + 256 * j); v[u][j] = v[u][j] + fv[j] * r * g; }
            }
            if (xout) {
#pragma unroll
                for (int j = 0; j < 4; ++j) __builtin_nontemporal_store(v[u][j], (f32x4*)(xout + (size_t)row * DM + 4 * lane + 256 * j));
            }
            if (xb) {
                float ss = 0.f;
#pragma unroll
                for (int j = 0; j < 4; ++j) ss += dot4(v[u][j]);
                const float r = rsqrtf(wave_sum(ss, lane) * (1.f / DM) + EPS);
#pragma unroll
                for (int j = 0; j < 4; ++j) { const f32x4 g = *(const f32x4*)(gnext + 4 * lane + 256 * j); const f32x4 y = v[u][j] * r * g;
                    u32x2 w; w.x = cvt_pk_bf16(y[0], y[1]); w.y = cvt_pk_bf16(y[2], y[3]); __builtin_nontemporal_store(w, (u32x2*)(xb + (size_t)row * DM + 4 * lane + 256 * j)); }
            }
        }
    }
}
__device__ __forceinline__ void rowpass_x(const float* xin, const bf16_t* f, const float* gpost, float* xout, const float* gnext, bf16_t* xb, float* ssqz, int rows, int gw, int nw, int lane, const bf16_t* f2 = nullptr, const float* gpost2 = nullptr) {
    (void)ssqz;
    if (f2) rowpass_x_t<true, 2, true>(xin, f, gpost, xout, gnext, xb, rows, gw, nw, lane, f2, gpost2);
    else if (f) rowpass_x_t<true, 4>(xin, f, gpost, xout, gnext, xb, rows, gw, nw, lane);
    else   rowpass_x_t<false, 4>(xin, f, gpost, xout, gnext, xb, rows, gw, nw, lane);
}
__device__ __forceinline__ void rowpass_ret(const bf16_t* retf, const bf16_t* retb, const bf16_t* rg, const float* gng, bf16_t* rety, int rows, int gw, int nw, int lane) {
    for (int row = gw; row < rows; row += nw) {
#pragma unroll
        for (int hh = 0; hh < 4; ++hh) {
            const size_t o = (size_t)row * 1024 + hh * 256 + 4 * lane;
            const u32x2 wf = __builtin_nontemporal_load((const u32x2*)(retf + o)), wb = __builtin_nontemporal_load((const u32x2*)(retb + o)), wg = __builtin_nontemporal_load((const u32x2*)(rg + o));
            f32x4 v = (f32x4){bf_lo(wf.x) + bf_lo(wb.x), bf_hi(wf.x) + bf_hi(wb.x), bf_lo(wf.y) + bf_lo(wb.y), bf_hi(wf.y) + bf_hi(wb.y)};
            const float mu = wave_sum((v[0] + v[1]) + (v[2] + v[3]), lane) * (1.f / 256.f);
            v = v - mu;
            const float rstd = rsqrtf(wave_sum(dot4(v), lane) * (1.f / 256.f) + EPS);
            const f32x4 g = *(const f32x4*)(gng + hh * 256 + 4 * lane);
            const f32x4 sg = (f32x4){bf_lo(wg.x), bf_hi(wg.x), bf_lo(wg.y), bf_hi(wg.y)};
            const f32x4 y = v * rstd * g * sg;
            u32x2 w; w.x = cvt_pk_bf16(y[0], y[1]); w.y = cvt_pk_bf16(y[2], y[3]); __builtin_nontemporal_store(w, (u32x2*)(rety + o));
        }
    }
}

__device__ __forceinline__ void lds_barrier() { asm volatile("s_waitcnt lgkmcnt(0)" ::: "memory"); __builtin_amdgcn_s_barrier(); asm volatile("" ::: "memory"); }
constexpr int AKP = 208, AVP = 136, ASTG = 64 * AKP + 64 * AVP;
__device__ __forceinline__ f32x16 mfma32(bf16x8 a, bf16x8 b, f32x16 c) { return __builtin_amdgcn_mfma_f32_32x32x16_bf16(a, b, c, 0, 0, 0); }
__device__ __forceinline__ f32x4 mfma16(bf16x8 a, bf16x8 b, f32x4 c) { return __builtin_amdgcn_mfma_f32_16x16x32_bf16(a, b, c, 0, 0, 0); }
__device__ __forceinline__ bf16x8 cat2(u32x2 lo, u32x2 hi) { u32x4 w; w.x = lo.x; w.y = lo.y; w.z = hi.x; w.w = hi.y; return __builtin_bit_cast(bf16x8, w); }

#define ATT_QK(Kb, d0, d1, iv) do { _Pragma("unroll") for (int i_ = 0; i_ < 16; ++i_) { d0[i_] = (iv); d1[i_] = (iv); } \
    _Pragma("unroll") for (int ks = 0; ks < 6; ++ks) { \
        const bf16x8 a0_ = *(const LAS bf16x8*)((Kb) + q32 * AKP + ks * 32 + hi * 16), a1_ = *(const LAS bf16x8*)((Kb) + (32 + q32) * AKP + ks * 32 + hi * 16); \
        d0 = mfma32(a0_, qf[ks], d0); d1 = mfma32(a1_, qf[ks], d1); } } while (0)
#define ATT_C(e) ((e) < 16 ? c0[(e) & 15] : c1[(e) & 15])
#define ATT_EXP2(c0, c1, e, SUB) do { if constexpr (MODE & 2) { } else if ((e) < 16) { c0[(e) & 15] = __builtin_amdgcn_exp2f(c0[(e) & 15] SUB); c0[((e) + 1) & 15] = __builtin_amdgcn_exp2f(c0[((e) + 1) & 15] SUB); ls2 = ls2 + (f32x2){c0[(e) & 15], c0[((e) + 1) & 15]}; } \
                              else { c1[(e) & 15] = __builtin_amdgcn_exp2f(c1[(e) & 15] SUB); c1[((e) + 1) & 15] = __builtin_amdgcn_exp2f(c1[((e) + 1) & 15] SUB); ls2 = ls2 + (f32x2){c1[(e) & 15], c1[((e) + 1) & 15]}; } } while (0)
#define ATT_VA(s2_, db_) cat2(*(const LAS u32x2*)(Vb + (q32 + 32 * (db_)) * AVP + (32 * ((s2_) >> 1) + 16 * ((s2_) & 1) + hi * 4) * 2), *(const LAS u32x2*)(Vb + (q32 + 32 * (db_)) * AVP + (32 * ((s2_) >> 1) + 16 * ((s2_) & 1) + hi * 4) * 2 + 16))
#define ATT_KF(ks_) (*(const LAS bf16x8*)(Kn + q32 * AKP + (ks_) * 32 + hi * 16))
#define ATT_KF2(ks_) (*(const LAS bf16x8*)(Kn + (32 + q32) * AKP + (ks_) * 32 + hi * 16))
#define ATT_ARM(c0, c1, n0, n1, SUB) do { \
        _Pragma("unroll") for (int i_ = 0; i_ < 16; ++i_) { n0[i_] = -m_init_n; n1[i_] = -m_init_n; } \
        bf16x8 ka0_ = ATT_KF(0), ka1_ = ATT_KF2(0); \
        _Pragma("unroll") for (int ks = 0; ks < 6; ++ks) { \
            bf16x8 kb0_ = ka0_, kb1_ = ka1_; \
            if (ks < 5) { kb0_ = ATT_KF(ks + 1); kb1_ = ATT_KF2(ks + 1); }        \
            if constexpr (!(MODE & 8)) { n0 = mfma32(ka0_, qf[ks], n0); n1 = mfma32(ka1_, qf[ks], n1); } \
            if (ks < 5) { ATT_EXP2(c0, c1, ks * 6 + 0, SUB); ATT_EXP2(c0, c1, ks * 6 + 2, SUB); ATT_EXP2(c0, c1, ks * 6 + 4, SUB); } else { ATT_EXP2(c0, c1, 30, SUB); } \
            __builtin_amdgcn_sched_barrier(0); ka0_ = kb0_; ka1_ = kb1_; } } while (0)
#define ATT_STEP(T, c0, c1, n0, n1, LK, LP, LV, WK, WP, WV, DOMAX) do { \
        const int t_ = (T), t3_ = t_ + 3 < SEQ / 64 ? t_ + 3 : SEQ / 64 - 1, t2_ = t_ + 2 < SEQ / 64 ? t_ + 2 : SEQ / 64 - 1;        \
        if constexpr (!(MODE & 1)) { LK = *(const u32x4*)(kn_p + (size_t)t3_ * 64 * 512); LP = *(const u32x4*)(kp_p + (size_t)t3_ * 64 * 32); LV = *(const u32x4*)(vt_p + (size_t)t2_ * 32768); } \
        LAS unsigned char* Kn = lds + ((t_ + 1) & 1) * ASTG; LAS unsigned char* Vb = lds + (t_ & 1) * ASTG + 64 * AKP; \
        const float m_init_n = m_now < -1e29f ? 0.f : m_now; \
        float mx = -1e30f;        \
        if (DOMAX) { mx = fmaxf(fmaxf(c0[0], c0[1]), c1[0]); \
        _Pragma("unroll") for (int i_ = 1; i_ < 16; i_ += 2) mx = fmaxf(fmaxf(mx, c0[i_]), (i_ + 1 < 16) ? c0[i_ + 1] : c0[i_]); \
        _Pragma("unroll") for (int i_ = 1; i_ < 16; i_ += 2) mx = fmaxf(fmaxf(mx, c1[i_]), (i_ + 1 < 16) ? c1[i_ + 1] : c1[i_]); \
        mx = fmaxf(mx, shx(mx, 32, lane)); } \
          \
          \
        const float d_ref = m_init - m_ref; \
        f32x2 ls2 = {0.f, 0.f}; \
        if (__builtin_amdgcn_ballot_w64(d_ref != 0.f) != 0) { \
            const float alpha = __builtin_amdgcn_exp2f(-d_ref); lrun *= alpha; \
            _Pragma("unroll") for (int i_ = 0; i_ < 16; ++i_) { o0[i_] *= alpha; o1[i_] *= alpha; } \
        } \
        m_ref = m_init; \
        { const float m_abs = m_init + mx; m_now = m_abs > m_now + 8.f ? m_abs : m_now; } \
        __builtin_amdgcn_sched_barrier(0); \
        ATT_ARM(c0, c1, n0, n1, ); \
        lrun += ls2.x + ls2.y; __builtin_amdgcn_sched_barrier(0); \
        bf16x8 va0_ = ATT_VA(0, 0), va1_ = ATT_VA(0, 1); \
        _Pragma("unroll") for (int s2 = 0; s2 < 4; ++s2) { \
            bf16x8 vb0_ = va0_, vb1_ = va1_; \
            if (s2 < 3) { vb0_ = ATT_VA(s2 + 1, 0); vb1_ = ATT_VA(s2 + 1, 1); } \
            const int i0 = 2 * (s2 & 1); u32x4 w_; \
            if (s2 < 2) { w_.x = cvt_pk_bf16(c0[i0 * 4 + 0], c0[i0 * 4 + 1]); w_.y = cvt_pk_bf16(c0[i0 * 4 + 2], c0[i0 * 4 + 3]); w_.z = cvt_pk_bf16(c0[i0 * 4 + 4], c0[i0 * 4 + 5]); w_.w = cvt_pk_bf16(c0[i0 * 4 + 6], c0[i0 * 4 + 7]); } \
            else        { w_.x = cvt_pk_bf16(c1[i0 * 4 + 0], c1[i0 * 4 + 1]); w_.y = cvt_pk_bf16(c1[i0 * 4 + 2], c1[i0 * 4 + 3]); w_.z = cvt_pk_bf16(c1[i0 * 4 + 4], c1[i0 * 4 + 5]); w_.w = cvt_pk_bf16(c1[i0 * 4 + 6], c1[i0 * 4 + 7]); } \
            const bf16x8 pb_ = __builtin_bit_cast(bf16x8, w_); \
            if constexpr (!(MODE & 4)) { o0 = mfma32(va0_, pb_, o0); o1 = mfma32(va1_, pb_, o1); } \
            __builtin_amdgcn_sched_barrier(0); va0_ = vb0_; va1_ = vb1_; } \
        __builtin_amdgcn_sched_barrier(0); \
        if constexpr (!(MODE & 1)) { LAS unsigned char* kw_ = lds + (t_ & 1) * ASTG; *(LAS u32x4*)(kw_ + wk) = WK; *(LAS u32x4*)(kw_ + wp) = WP; { LAS unsigned char* vw_ = lds + ((t_ + 1) & 1) * ASTG + wv; *(LAS u32x2*)vw_ = (u32x2){WV.x, WV.y}; *(LAS u32x2*)(vw_ + 8) = (u32x2){WV.z, WV.w}; } } \
        if constexpr (!(MODE & 16)) lds_barrier(); \
        m_init = m_init_n; \
    } while (0)
typedef float f32x2 __attribute__((ext_vector_type(2)));
template <int MODE = 0>
__device__ __forceinline__ void attn_unit(LAS unsigned char* lds, const bf16_t* Q, const bf16_t* KN, const bf16_t* KPE, const bf16_t* VT, bf16_t* O, int b, int h, int qb) {
    const int tid = otid(), wid = tid >> 6, lane = tid & 63, q32 = lane & 31, hi = lane >> 5;
    const size_t rowq = (size_t)b * SEQ + qb * 256 + wid * 32 + q32;
    bf16x8 qf[6];
#pragma unroll
    for (int ks = 0; ks < 4; ++ks) qf[ks] = *(const bf16x8*)(Q + rowq * 768 + h * 64 + ks * 16 + hi * 8);
#pragma unroll
    for (int ks = 0; ks < 2; ++ks) qf[4 + ks] = *(const bf16x8*)(Q + rowq * 768 + 512 + h * 32 + ks * 16 + hi * 8);
    f32x16 o0, o1;
#pragma unroll
    for (int i = 0; i < 16; ++i) { o0[i] = 0.f; o1[i] = 0.f; }
    float m_now = -1e30f, m_init = 0.f, m_ref = 0.f, lrun = 0.f;
    const int kkey = tid >> 3, kc = tid & 7, pkey = (tid & 255) >> 2, pc = tid & 3;
    const bf16_t* kn_p = KN + ((size_t)b * SEQ + kkey) * 512 + h * 64 + kc * 8;
    const bf16_t* kp_p = KPE + ((size_t)b * SEQ + pkey) * 32 + pc * 8;
    const bf16_t* vt_p = VT + ((((size_t)b * 64) * 8 + (kkey >> 3)) * 8 + h) * 512 + (kkey & 7) * 64 + kc * 8;
    const int wk = kkey * AKP + kc * 16, wp = pkey * AKP + 128 + pc * 16, wv = 64 * AKP + kkey * AVP + kc * 16;
    u32x4 rk, rp, rv;
    rk = *(const u32x4*)kn_p; rp = *(const u32x4*)kp_p; rv = *(const u32x4*)vt_p;
    *(LAS u32x4*)(lds + wk) = rk; *(LAS u32x4*)(lds + wp) = rp; *(LAS u32x2*)(lds + wv) = (u32x2){rv.x, rv.y}; *(LAS u32x2*)(lds + wv + 8) = (u32x2){rv.z, rv.w};
    rk = *(const u32x4*)(kn_p + (size_t)64 * 512); rp = *(const u32x4*)(kp_p + (size_t)64 * 32);
    *(LAS u32x4*)(lds + ASTG + wk) = rk; *(LAS u32x4*)(lds + ASTG + wp) = rp;
    u32x4 rk2 = *(const u32x4*)(kn_p + (size_t)2 * 64 * 512), rp2 = *(const u32x4*)(kp_p + (size_t)2 * 64 * 32), rv2 = *(const u32x4*)(vt_p + (size_t)32768);
    lds_barrier();
    f32x16 sa0, sa1, sb0, sb1;
    ATT_QK(lds, sa0, sa1, 0.f);
    lds_barrier();
#pragma unroll
    for (int i = 0; i < 16; ++i) { sb0[i] = 0.f; sb1[i] = 0.f; }
    for (int kt = 0; kt < SEQ / 64; kt += 2) {
        ATT_STEP(kt, sa0, sa1, sb0, sb1, rk, rp, rv, rk2, rp2, rv2, (kt & 3) == 0);
        ATT_STEP(kt + 1, sb0, sb1, sa0, sa1, rk2, rp2, rv2, rk, rp, rv, false);
    }
    const float lt = lrun + shx(lrun, 32, lane), inv = __builtin_amdgcn_rcpf(lt);
    bf16_t* op = O + rowq * 512 + h * 64 + hi * 4;
#pragma unroll
    for (int i = 0; i < 4; ++i) {
        u32x2 w; w.x = cvt_pk_bf16(o0[i * 4 + 0] * inv, o0[i * 4 + 1] * inv); w.y = cvt_pk_bf16(o0[i * 4 + 2] * inv, o0[i * 4 + 3] * inv); *(u32x2*)(op + 8 * i) = w;
        u32x2 w2; w2.x = cvt_pk_bf16(o1[i * 4 + 0] * inv, o1[i * 4 + 1] * inv); w2.y = cvt_pk_bf16(o1[i * 4 + 2] * inv, o1[i * 4 + 3] * inv); *(u32x2*)(op + 32 + 8 * i) = w2;
    }
}

typedef float f32x2v __attribute__((ext_vector_type(2)));
__device__ __forceinline__ void conv_unit(LAS unsigned char* lds, const bf16_t* CA, const float* wdw, const float* bdw, const float* lng, const float* lnb, bf16_t* CY, int b, int tt) {
    const int tid = otid(), wid = tid >> 6, lane = tid & 63, t0 = tt * 32;
    {
        u32x4 rr[8]; f32x4 ww[8];
#pragma unroll
        for (int i = 0; i < 8; ++i) { const int id = tid + 512 * i, r = id >> 6, ck = id & 63, s = t0 + r - 15;
            rr[i] = (r < 62 && s >= 0 && s < SEQ) ? *(const u32x4*)(CA + ((size_t)b * SEQ + s) * 512 + ck * 8) : (u32x4){0u, 0u, 0u, 0u};
            ww[i] = id < 31 * 128 ? *(const f32x4*)(wdw + id * 4) : (f32x4){0.f, 0.f, 0.f, 0.f}; }
#pragma unroll
        for (int i = 0; i < 8; ++i) { const int id = tid + 512 * i; if (id < 62 * 64) { *(LAS u32x4*)(lds + id * 16) = rr[i]; *(LAS f32x4*)(lds + 65536 + id * 16) = ww[i]; } }
    }
    f32x2v acc2[16]; const float bias = bdw[tid];
#pragma unroll
    for (int t = 0; t < 16; ++t) acc2[t] = (f32x2v){bias, bias};
    __syncthreads();
    const LAS unsigned short* col = (const LAS unsigned short*)lds + tid;
    const LAS float* wcol = (const LAS float*)(lds + 65536) + tid;
#pragma unroll 1
    for (int k = 0; k < 31; ++k) {
        const float wk = wcol[k * 512];
        const LAS unsigned short* ck = col + k * 512;
#pragma unroll
        for (int t = 0; t < 16; ++t) { const f32x2v a2 = {bf2f(ck[(2 * t) * 512]), bf2f(ck[(2 * t + 1) * 512])}; acc2[t] = a2 * wk + acc2[t]; }
    }
    __syncthreads();
    LAS float* yb = (LAS float*)lds;
#pragma unroll
    for (int t = 0; t < 16; ++t) { yb[(2 * t) * 512 + tid] = acc2[t].x; yb[(2 * t + 1) * 512 + tid] = acc2[t].y; }
    __syncthreads();
    const f32x4 g0 = *(const f32x4*)(lng + lane * 8), g1 = *(const f32x4*)(lng + lane * 8 + 4), bb0 = *(const f32x4*)(lnb + lane * 8), bb1 = *(const f32x4*)(lnb + lane * 8 + 4);
#pragma unroll
    for (int j = 0; j < 4; ++j) {
        const int t = wid * 4 + j;
        f32x4 v0 = *(const LAS f32x4*)(yb + t * 512 + lane * 8), v1 = *(const LAS f32x4*)(yb + t * 512 + lane * 8 + 4);
        const float mu = wave_sum(((v0[0] + v0[1]) + (v0[2] + v0[3])) + ((v1[0] + v1[1]) + (v1[2] + v1[3])), lane) * (1.f / 512.f);
        v0 = v0 - mu; v1 = v1 - mu;
        const float rstd = rsqrtf(wave_sum(dot4(v0) + dot4(v1), lane) * (1.f / 512.f) + EPS);
        v0 = v0 * rstd * g0 + bb0; v1 = v1 * rstd * g1 + bb1;
        store8(CY + ((size_t)b * SEQ + t0 + t) * 512 + lane * 8, v0 * sigm4(v0), v1 * sigm4(v1));
    }
    __syncthreads();
}

__device__ __forceinline__ void ret_unit(LAS unsigned char* lds, const bf16_t* RQ, const bf16_t* RK, const bf16_t* RV, bf16_t* OUT, float lg2, int b, int h, int dir, int eh) {
    constexpr int KS = 0, KT = 32768, VTO = 65536, ST = 98304;
    const int tid = otid(), w = tid >> 6, lane = tid & 63, l16 = lane & 15, lq = lane >> 4;
    f32x4 st[8];
#pragma unroll
    for (int i = 0; i < 8; ++i) st[i] = (f32x4){0.f, 0.f, 0.f, 0.f};
    const float cdec = exp2f(lg2 * 128.f);
    const int tok0 = tid >> 4, dc = tid & 15;
    float kd[4];
#pragma unroll
    for (int i = 0; i < 4; ++i) { const int tok = tok0 + 32 * i; kd[i] = exp2f(lg2 * (float)(dir == 0 ? 127 - tok : tok)); }
    const int qloc = 16 * w + l16;
    const float cf = exp2f(lg2 * (float)(dir == 0 ? qloc + 1 : 128 - qloc));
    const int sw = l16 ^ (l16 >> 3);
    const unsigned rb16_0 = l16 * 256 + (((lq ^ sw) & 15) << 4);
    const unsigned rb8_0 = l16 * 256 + ((((lq >> 1) ^ sw) & 15) << 4) + (lq & 1) * 8;
    const unsigned wbK_0 = tok0 * 256 + (((dc ^ (tok0 & 15) ^ (tok0 >> 3)) & 15) << 4);
    const unsigned wbT_0 = dc * 2048 + ((((tok0 >> 3) ^ ((dc & 1) * 8) ^ dc) & 15) << 4) + (tok0 & 7) * 2;
    const unsigned wbS_0 = l16 * 256 + ((((2 * w) ^ (lq >> 1) ^ sw) & 15) << 4) + (lq & 1) * 8;
    u32x4 kreg[4], vreg[4]; bf16x8 qn[4];
    {
        const int c = dir == 0 ? 0 : 31; const size_t row0 = (size_t)b * SEQ + c * 128;
#pragma unroll
        for (int i = 0; i < 4; ++i) { kreg[i] = *(const u32x4*)(RK + (row0 + tok0 + 32 * i) * 512 + h * 128 + dc * 8); vreg[i] = *(const u32x4*)(RV + (row0 + tok0 + 32 * i) * 1024 + h * 256 + eh * 128 + dc * 8); }
#pragma unroll
        for (int ks = 0; ks < 4; ++ks) qn[ks] = *(const bf16x8*)(RQ + (row0 + qloc) * 512 + h * 128 + 32 * ks + lq * 8);
    }
    for (int it = 0; it < 32; ++it) {
        const int c = dir == 0 ? it : 31 - it; const size_t row0 = (size_t)b * SEQ + c * 128;
        unsigned rb16 = rb16_0, rb8 = rb8_0, wbK = wbK_0, wbT = wbT_0, wbS = wbS_0;
        asm volatile("" : "+v"(rb16), "+v"(rb8), "+v"(wbK), "+v"(wbT), "+v"(wbS));
#define R16(tile, blk, cc) (*(const LAS bf16x8*)(lds + (tile) + (blk) * 4096 + (rb16 ^ ((((cc)) & 15) << 4))))
#define R8(tile, blk, cc) (*(const LAS u32x2*)(lds + (tile) + (blk) * 4096 + (rb8 ^ ((((cc)) & 15) << 4))))
#pragma unroll
        for (int i = 0; i < 4; ++i) {
            *(LAS u32x4*)(lds + KS + i * 8192 + (wbK ^ ((4 * i) << 4))) = kreg[i];
            const unsigned kw[4] = {kreg[i].x, kreg[i].y, kreg[i].z, kreg[i].w}, vw[4] = {vreg[i].x, vreg[i].y, vreg[i].z, vreg[i].w};
#pragma unroll
            for (int jj = 0; jj < 8; ++jj) {
                const unsigned kwv = kw[jj >> 1], vwv = vw[jj >> 1];
                const float kf = ((jj & 1) ? bf_hi(kwv) : bf_lo(kwv)) * kd[i];
                const unsigned ad = jj * 256 + (wbT ^ (((4 * i) ^ jj) << 4));
                *(LAS unsigned short*)(lds + KT + ad) = f2bf(kf);
                *(LAS unsigned short*)(lds + VTO + ad) = (unsigned short)((jj & 1) ? (vwv >> 16) : (vwv & 0xffffu));
            }
        }
#pragma unroll
        for (int eb = 0; eb < 8; ++eb) { u32x2 wv; wv.x = cvt_pk_bf16(st[eb][0], st[eb][1]); wv.y = cvt_pk_bf16(st[eb][2], st[eb][3]); *(LAS u32x2*)(lds + ST + eb * 4096 + (wbS ^ ((2 * eb) << 4))) = wv; }
        bf16x8 qf[4];
#pragma unroll
        for (int ks = 0; ks < 4; ++ks) qf[ks] = qn[ks];
        __syncthreads();
        if (it + 1 < 32) {
            const int cn = dir == 0 ? it + 1 : 30 - it; const size_t rn = (size_t)b * SEQ + cn * 128;
#pragma unroll
            for (int i = 0; i < 4; ++i) { kreg[i] = *(const u32x4*)(RK + (rn + tok0 + 32 * i) * 512 + h * 128 + dc * 8); vreg[i] = *(const u32x4*)(RV + (rn + tok0 + 32 * i) * 1024 + h * 256 + eh * 128 + dc * 8); }
#pragma unroll
            for (int ks = 0; ks < 4; ++ks) qn[ks] = *(const bf16x8*)(RQ + (rn + qloc) * 512 + h * 128 + 32 * ks + lq * 8);
        }
        bf16x8 pb[4];
#pragma unroll
        for (int s = 0; s < 4; ++s) {
            f32x4 sc[2];
#pragma unroll
            for (int x = 0; x < 2; ++x) {
                const int kb = 2 * s + x; f32x4 a4 = (f32x4){0.f, 0.f, 0.f, 0.f};
#pragma unroll
                for (int ks = 0; ks < 4; ++ks) a4 = mfma16(R16(KS, kb, (4 * ks) ^ (2 * kb)), qf[ks], a4);
#pragma unroll
                for (int j = 0; j < 4; ++j) { const int k = 16 * kb + lq * 4 + j; const int df = dir == 0 ? qloc - k : k - qloc; const bool on = dir == 0 ? df >= 0 : df > 0;
                    a4[j] = on ? a4[j] * __builtin_amdgcn_exp2f(lg2 * (float)df) : 0.f; }
                sc[x] = a4;
            }
            pb[s] = __builtin_bit_cast(bf16x8, pack8(sc[0], sc[1]));
        }
        bf16_t* op = OUT + (row0 + qloc) * 1024 + h * 256 + eh * 128 + lq * 4;
#pragma unroll
        for (int eb = 0; eb < 8; ++eb) {
            f32x4 a4 = (f32x4){0.f, 0.f, 0.f, 0.f};
#pragma unroll
            for (int ks = 0; ks < 4; ++ks) a4 = mfma16(R16(ST, eb, (4 * ks) ^ (2 * eb)), qf[ks], a4);
            a4 = a4 * cf;
#pragma unroll
            for (int s = 0; s < 4; ++s) {
                const bf16x8 A = cat2(R8(VTO, eb, (4 * s) ^ (2 * eb)), R8(VTO, eb, (4 * s) ^ 2 ^ (2 * eb)));
                a4 = mfma16(A, pb[s], a4);
            }
            u32x2 wv; wv.x = cvt_pk_bf16(a4[0], a4[1]); wv.y = cvt_pk_bf16(a4[2], a4[3]); *(u32x2*)(op + 16 * eb) = wv;
        }
        bf16x8 ka[4];
#pragma unroll
        for (int s = 0; s < 4; ++s) ka[s] = R16(KT, w, (4 * s) ^ (2 * w));
#pragma unroll
        for (int eb = 0; eb < 8; ++eb) {
            f32x4 a4 = st[eb] * cdec;
#pragma unroll
            for (int s = 0; s < 4; ++s) a4 = mfma16(ka[s], R16(VTO, eb, (4 * s) ^ (2 * eb)), a4);
            st[eb] = a4;
        }
        __syncthreads();
#undef R16
#undef R8
    }
}

#define XB_TMO      128
#define XB_XCNT(j)  (256  + 64 * (j))
#define XB_XSUB(j)  (1280 + 64 * (j))
#define XB_XGEN(j)  (2304 + 64 * (j))
#define XB_TOP      3328
#define XB_TOPGEN   3392
#define XB_SPIN_CAP (1u << 18)
__device__ __forceinline__ unsigned xb_ld(unsigned* p)              { return __hip_atomic_load(p, __ATOMIC_RELAXED, __HIP_MEMORY_SCOPE_AGENT); }
__device__ __forceinline__ unsigned xb_add(unsigned* p, unsigned v) { return __hip_atomic_fetch_add(p, v, __ATOMIC_RELAXED, __HIP_MEMORY_SCOPE_AGENT); }
__device__ __forceinline__ unsigned xb_xcc_id() { return (unsigned)__builtin_amdgcn_s_getreg((3 << 11) | 20) & 0xFu; }
#define XB_SPIN(cond, bar) do { unsigned _sp = 0; while (cond) { __builtin_amdgcn_s_sleep(1); \
    if ((++_sp & 255u) == 0u) { if (xb_ld(&(bar)[XB_TMO])) break; if (_sp > XB_SPIN_CAP) { atomicAdd(&(bar)[XB_TMO], 1u); break; } } } } while (0)
__device__ __forceinline__ void xcd_barrier_complete(unsigned* bar, unsigned x, unsigned G, unsigned& nloc, unsigned& nx) {
    unsigned sum, cnt, mine, sp = 0u;
    for (;;) {
        sum = 0u; cnt = 0u; mine = 0u;
#pragma unroll
        for (unsigned j = 0; j < 16; ++j) { const unsigned c = xb_ld(&bar[XB_XCNT(j)]); sum += c; cnt += (c > 0u) ? 1u : 0u; mine = (j == x) ? c : mine; }
        if (sum == G) break;
        __builtin_amdgcn_s_sleep(1);
        if ((++sp & 255u) == 0u) { if (xb_ld(&bar[XB_TMO])) break; if (sp > XB_SPIN_CAP) { atomicAdd(&bar[XB_TMO], 1u); break; } }
    }
    nloc = mine > 0u ? mine : 1u; nx = cnt > 0u ? cnt : 1u;
}
__device__ __forceinline__ void xcd_barrier(unsigned* bar, volatile LAS unsigned* st, unsigned G, int tid) {
    asm volatile("s_waitcnt vmcnt(0)" ::: "memory");
    __syncthreads();
    if (tid == 0) {
        __builtin_amdgcn_s_waitcnt(0);
        const unsigned x = xb_xcc_id();
        unsigned nloc = st[0], nx = st[1];
        if (nloc == 0u) { xcd_barrier_complete(bar, x, G, nloc, nx); st[0] = nloc; st[1] = nx; }
        const unsigned old = xb_add(&bar[XB_XSUB(x)], 1u);
        const unsigned gen = old / nloc;
        if (old + 1u == (gen + 1u) * nloc) {
            __builtin_amdgcn_fence(__ATOMIC_RELEASE, "agent");
            asm volatile("s_waitcnt vmcnt(0)" ::: "memory");
            const unsigned og = xb_add(&bar[XB_TOP], 1u);
            const unsigned tg = og / nx;
            if (og + 1u == (tg + 1u) * nx) xb_add(&bar[XB_TOPGEN], 1u);
            else XB_SPIN(xb_ld(&bar[XB_TOPGEN]) == tg, bar);
            __builtin_amdgcn_fence(__ATOMIC_ACQUIRE, "agent");
            xb_add(&bar[XB_XGEN(x)], 1u);
            asm volatile("s_waitcnt vmcnt(0)" ::: "memory");
        } else {
            XB_SPIN(xb_ld(&bar[XB_XGEN(x)]) == gen, bar);
            __builtin_amdgcn_fence(__ATOMIC_ACQUIRE, "agent");
            asm volatile("s_waitcnt vmcnt(0)" ::: "memory");
        }
    }
    __syncthreads();
}
#define WSP(T, off) ((T*)(ws + (off)))
__global__ void __launch_bounds__(512, 2) fwd_megakernel(Params P) {
    extern __shared__ __attribute__((aligned(16))) unsigned char lds_raw[];
    LAS unsigned char* lds = (LAS unsigned char*)lds_raw;
    cg::grid_group grid = cg::this_grid();
#ifdef REPEAT_K
    constexpr int NPL = 11;
#else
    constexpr int NPL = 10;
#endif
    constexpr int NPH = 1 + NG * (1 + DEPTH * NPL);
    {
        volatile LAS unsigned* st0 = (volatile LAS unsigned*)(lds + LDS_MISC + 16);
        if (threadIdx.x == 0) { st0[0] = 0u; st0[1] = 0u; kptr_t kp = (kptr_t)__builtin_amdgcn_kernarg_segment_ptr(); (void)xb_add((unsigned*)(PWS + WS_CTL) + 2048 + XB_XCNT(xb_xcc_id()), 1u); }
        __syncthreads();
    }
    grid.sync();
    for (int ph = 0; ph < NPH; ++ph) {
        int G = (int)gridDim.x, bid = (int)blockIdx.x; asm volatile("" : "+s"(G), "+s"(bid));
        const int nw = G * 8;
        const int tid = otid(), wid = tid >> 6, lane = tid & 63, gw = bid * 8 + wid;
        kptr_t kp = (kptr_t)__builtin_amdgcn_kernarg_segment_ptr(); asm volatile("" : "+s"(kp));
        unsigned char* const ws = PWS;
        if (ph == 0) {
#ifndef NO_PRO
            prologue(kp, lds, gw, nw, wid, lane, 0, 1, true);
#endif
#ifdef PRO_X
            __syncthreads(); prologue(kp, lds, gw, nw, wid, lane);
#endif
        } else {
            const int qq = ph - 1, g = qq / (1 + DEPTH * NPL), r = qq % (1 + DEPTH * NPL);
            const size_t tokoff = (size_t)g * MG;
            const float* xg = PIN(0) + tokoff * DM; float* og = POUT + tokoff * DM;
            if (r == 0) {
                rowpass_x(xg, nullptr, nullptr, nullptr, PIN(2), WSP(bf16_t, WS_XB), WSP(float, WS_SSQ), MG, gw, nw, lane);
            } else {
#ifdef REPEAT_K
                const int l = (r - 1) / NPL, kp = (r - 1) % NPL, k = kp > REPEAT_K ? kp - 1 : kp, rep = kp == REPEAT_K + 1;
#else
                const int l = (r - 1) / NPL, k = (r - 1) % NPL; constexpr int rep = 0;
#endif
                const unsigned char* wl = ws + WS_W + (size_t)l * WL_BYTES;
                StaticOrder so;
                switch (k) {
                case 0: {
                    EpiIn e; e.cqkv = WSP(bf16_t, WS_CQKV); e.kpe = WSP(bf16_t, WS_KPE); e.conva = WSP(bf16_t, WS_CONVA); e.rq = WSP(bf16_t, WS_RQ); e.rk = WSP(bf16_t, WS_RK); e.rv = WSP(bf16_t, WS_RV);
                    e.rg = WSP(bf16_t, WS_RG); e.gates = WSP(bf16_t, WS_GATES); e.ssq = WSP(float, WS_SSQ);
                    e.cosr = WSP(const float, WS_COSR) + tokoff * 64; e.sinr = WSP(const float, WS_SINR) + tokoff * 64; e.cosm = WSP(const float, WS_COSM) + tokoff * 16; e.sinm = WSP(const float, WS_SINM) + tokoff * 16;
                    Gemm gm{WSP(const bf16_t, WS_XB), (const bf16_t*)(wl + OFF_WIN), MG, NIN, DM}; so.init(MG, NIN, G, bid); pg8::gemm_phase<EpiIn, StaticOrder, true, true>(lds, gm, so, e);
#ifdef TWICE_IN
                    __syncthreads(); pg8::gemm_phase<EpiIn, StaticOrder, true, true>(lds, gm, so, e);
#endif
                } break;
                case 1: {
                    EpiQKV e; e.q = WSP(bf16_t, WS_Q); e.kn = WSP(bf16_t, WS_KN); e.vt = WSP(bf16_t, WS_VT); e.ssq = WSP(const float, WS_SSQ); e.cosm = WSP(const float, WS_COSM) + tokoff * 16; e.sinm = WSP(const float, WS_SINM) + tokoff * 16;
                    int kq = KQKV; asm volatile("" : "+s"(kq));
                    Gemm gm{WSP(const bf16_t, WS_CQKV), (const bf16_t*)(wl + OFF_WQKV), MG, NQKV, kq}; so.init(MG, NQKV, G, bid); pg8::gemm_phase<EpiQKV, StaticOrder, true, true>(lds, gm, so, e);
                } break;
                case 2: {
                    #ifndef RET_X
#define RET_X 1
#endif
#ifndef ATT_X
#define ATT_X 1
#endif
#ifndef CONV_X
#define CONV_X 1
#endif
                    constexpr int NRET1 = GB * 4 * 2 * 2, NATT1 = GB * 8 * (SEQ / 256), NRET = NRET1 * RET_X, NATT = NATT1 * ATT_X, NCONV1 = GB * (SEQ / 32), NCONV = NCONV1 * CONV_X, NTOT = NRET + NATT + NCONV;
                    constexpr int NPRO = 256;
                    unsigned* ctr = WSP(unsigned, WS_CTL) + (g * DEPTH + l) + rep * 16;
                    volatile LAS unsigned* uw = (volatile LAS unsigned*)(lds + LDS_MISC);
                    for (;;) {
                        __syncthreads();
                        if (tid == 0) *uw = atomicAdd(ctr, 1u);
                        __syncthreads();
                        const int uidx = (int)*uw;
                        const int npro = (g == 0 && l == 0) ? NPRO : 0;
                        if (uidx >= NTOT + npro) break;
                        if (uidx >= NTOT) { prologue(kp, lds, (uidx - NTOT) * 8 + wid, NPRO * 8, wid, lane, 1, DEPTH, false); continue; }
                        if (uidx < NRET) {
#ifndef NO_RET
                            const int u1 = uidx % NRET1, eh = u1 & 1, dir = (u1 >> 1) & 1, hh = (u1 >> 2) & 3, b = u1 >> 4;
                            const float lgt = PIN(17)[l * 8 + dir * 4 + hh];
                            const float lsg = fminf(lgt, 0.f) - log1pf(expf(-fabsf(lgt)));
                            ret_unit(lds, WSP(const bf16_t, WS_RQ), WSP(const bf16_t, WS_RK), WSP(const bf16_t, WS_RV), dir == 0 ? WSP(bf16_t, WS_RETF) : WSP(bf16_t, WS_RETB), lsg * 1.4426950408889634f, b, hh, dir, eh);
#endif
                        } else if (uidx < NRET + NATT) {
                            const int v = (uidx - NRET) % NATT1, qb = v & 15, hh = (v >> 4) & 7, b = v >> 7;
#ifdef ATT_PROBE
                            if (uidx - NRET >= NATT1) attn_unit<ATT_PROBE>(lds, WSP(const bf16_t, WS_Q), WSP(const bf16_t, WS_KN), WSP(const bf16_t, WS_KPE), WSP(const bf16_t, WS_VT), (bf16_t*)(ws + WS_F2), b, hh, qb); else
#endif
                            attn_unit<0>(lds, WSP(const bf16_t, WS_Q), WSP(const bf16_t, WS_KN), WSP(const bf16_t, WS_KPE), WSP(const bf16_t, WS_VT), WSP(bf16_t, WS_OMLA), b, hh, qb);
                        } else {
                            const int v = (uidx - NRET - NATT) % NCONV1, tt = v & 127, b = v >> 7;
#ifndef NO_CONV
                            conv_unit(lds, WSP(const bf16_t, WS_CONVA), PIN(12) + l * 31 * 512, PIN(13) + l * 512, PIN(14) + l * 512, PIN(15) + l * 512, WSP(bf16_t, WS_CONVY), b, tt);
#endif
                        }
                    }
                } break;
                case 3:
                    rowpass_ret(WSP(const bf16_t, WS_RETF), WSP(const bf16_t, WS_RETB), WSP(const bf16_t, WS_RG), PIN(18) + l * 1024, WSP(bf16_t, WS_XB), MG, gw, nw, lane);
#ifdef RP_X
                    rowpass_ret(WSP(const bf16_t, WS_RETF), WSP(const bf16_t, WS_RETB), WSP(const bf16_t, WS_RG), PIN(18) + l * 1024, WSP(bf16_t, WS_XB), MG, gw, nw, lane);
#endif
                    break;
                case 4: {
                    so.init(MG, DM, G, bid);
                    { EpiMerge<0> e0; e0.merged = WSP(bf16_t, WS_RV); e0.gates = WSP(const bf16_t, WS_GATES); e0.gi = 0; Gemm gm{WSP(const bf16_t, WS_OMLA), (const bf16_t*)(wl + OFF_WMO), MG, DM, 512}; pg8::gemm_phase<EpiMerge<0>, StaticOrder, true, true>(lds, gm, so, e0); }
                    { EpiMerge<1> e1; e1.merged = WSP(bf16_t, WS_RV); e1.gates = WSP(const bf16_t, WS_GATES); e1.gi = 1; Gemm gm{WSP(const bf16_t, WS_CONVY), (const bf16_t*)(wl + OFF_WPW), MG, DM, 512}; pg8::gemm_phase<EpiMerge<1>, StaticOrder, true, true>(lds, gm, so, e1); }
                    { EpiMerge<1> e2; e2.merged = WSP(bf16_t, WS_RV); e2.gates = WSP(const bf16_t, WS_GATES); e2.gi = 2; Gemm gm{WSP(const bf16_t, WS_XB), (const bf16_t*)(wl + OFF_WRO), MG, DM, DM}; pg8::gemm_phase<EpiMerge<1>, StaticOrder, true, true>(lds, gm, so, e2); }
                } break;
                case 5: {
                    EpiPlain e; e.o = WSP(bf16_t, WS_RG); e.ldc = DM; Gemm gm{WSP(const bf16_t, WS_RV), (const bf16_t*)(wl + OFF_WOUT), MG, DM, DM}; so.init(MG, DM, G, bid); pg8::gemm_phase<EpiPlain, StaticOrder, true, true>(lds, gm, so, e);
                } break;
                case 6:
                    rowpass_x(l == 0 ? xg : og, WSP(const bf16_t, WS_RG), PIN(3) + l * DM, nullptr, PIN(4) + l * DM, WSP(bf16_t, WS_XB), nullptr, MG, gw, nw, lane);
                    break;
                case 7: {
                    EpiSwiGLU e; e.hid = WSP(bf16_t, WS_GATES); Gemm gm{WSP(const bf16_t, WS_XB), (const bf16_t*)(wl + OFF_WGU), MG, NGU, DM}; so.init(MG, NGU, G, bid); pg8::gemm_phase<EpiSwiGLU, StaticOrder, true, true>(lds, gm, so, e);
#ifdef TWICE_UP
                    __syncthreads(); pg8::gemm_phase<EpiSwiGLU, StaticOrder, true, true>(lds, gm, so, e);
#endif
                } break;
                case 8: {
                    EpiPlain e; e.o = WSP(bf16_t, WS_F2); e.ldc = DM; Gemm gm{WSP(const bf16_t, WS_GATES), (const bf16_t*)(wl + OFF_WDN), MG, DM, FFH}; so.init(MG, DM, G, bid); pg8::gemm_phase<EpiPlain, StaticOrder, true, true>(lds, gm, so, e);
                } break;
                default:
                    rowpass_x(l == 0 ? xg : og, WSP(const bf16_t, WS_RG), PIN(3) + l * DM, og, l + 1 < DEPTH ? PIN(2) + (l + 1) * DM : nullptr, l + 1 < DEPTH ? WSP(bf16_t, WS_XB) : nullptr, nullptr, MG, gw, nw, lane, WSP(const bf16_t, WS_F2), PIN(5) + l * DM);
                    break;
                }
            }
        }
        xcd_barrier(WSP(unsigned, WS_CTL) + 2048, (volatile LAS unsigned*)(lds + LDS_MISC + 16), (unsigned)G, tid);
#ifdef SYNC_X
        xcd_barrier(WSP(unsigned, WS_CTL) + 2048, (volatile LAS unsigned*)(lds + LDS_MISC + 16), (unsigned)G, tid); xcd_barrier(WSP(unsigned, WS_CTL) + 2048, (volatile LAS unsigned*)(lds + LDS_MISC + 16), (unsigned)G, tid);
#endif
#ifdef DIAG_STOP
        if (ph == DIAG_STOP) {
            const unsigned short* da = (const unsigned short*)(ws + DIAG_A); const unsigned short* db = (const unsigned short*)(ws + DIAG_B); float* o = POUT;
            for (size_t i = (size_t)blockIdx.x * 512 + tid; i < (size_t)MTOT * DM; i += (size_t)G * 512) o[i] = bf2f(da[i]) + bf2f(db[i % ((size_t)MG * 1024)]);
            return;
        }
#endif
    }
}

extern "C" void kernel_launch(void* const* d_in, const int* in_sizes, int n_in, void* d_out, int out_size, void* d_ws, size_t ws_size, hipStream_t stream) {
    static int grid_blocks = 0;
    if (grid_blocks == 0) {
        if (n_in != 24 || out_size != MTOT * DM || ws_size < WS_END) { fprintf(stderr, "kernel_launch: unexpected shapes (n_in %d out %d ws %zu need %zu)\n", n_in, out_size, ws_size, (size_t)WS_END); grid_blocks = -1; return; }
        int dev = 0, cus = 0, per_cu = 0;
        (void)hipGetDevice(&dev); (void)hipDeviceGetAttribute(&cus, hipDeviceAttributeMultiprocessorCount, dev);
        if (hipFuncSetAttribute((const void*)fwd_megakernel, hipFuncAttributeMaxDynamicSharedMemorySize, LDS_BYTES) != hipSuccess) { fprintf(stderr, "kernel_launch: hipFuncSetAttribute failed\n"); grid_blocks = -1; return; }
        if (hipOccupancyMaxActiveBlocksPerMultiprocessor(&per_cu, (const void*)fwd_megakernel, 512, LDS_BYTES) != hipSuccess || per_cu < 1) per_cu = 1;
        (void)hipGetLastError();
        grid_blocks = cus * per_cu;
    }
    if (grid_blocks < 0) return;
    (void)hipMemsetAsync((unsigned char*)d_ws + WS_CTL, 0, CTL_BYTES, stream);
    Params p{};
    for (int i = 0; i < 24; ++i) p.in[i] = (const float*)d_in[i];
    p.out = (float*)d_out; p.ws = (unsigned char*)d_ws;
    void* args[] = {&p};
    hipError_t e = hipLaunchCooperativeKernel((const void*)fwd_megakernel, dim3(grid_blocks), dim3(512), args, LDS_BYTES, stream);
    if (e != hipSuccess) fprintf(stderr, "cooperative launch failed: %s (grid %d)\n", hipGetErrorString(e), grid_blocks);
}
```

```cpp
#include <hip/hip_runtime.h>
#include <hip/hip_cooperative_groups.h>
#include <cstdio>
#include <cstdint>
namespace cg = cooperative_groups;
namespace pg8 {
#define PG8_LAS __attribute__((address_space(3)))
typedef unsigned short bf16_t;
typedef short bf16x8 __attribute__((ext_vector_type(8)));
typedef float f32x4 __attribute__((ext_vector_type(4)));
typedef unsigned u32x4 __attribute__((ext_vector_type(4)));
constexpr int BM = 256, BK = 64, HALF = 128, HTB = HALF * BK * 2  , STAGE_BYTES = 8 * HTB, NXCD = 8, WGM = 8;

__host__ __device__ __forceinline__ int lds_byte(int r, int c) { const int st = (r >> 4) * 2 + (c >> 5), rr = r & 15, cc = c & 31, ob = rr * 64 + cc * 2; return st * 1024 + (ob ^ (((ob >> 9) & 1) << 5)); }
__host__ __device__ __forceinline__ void stage_rc(int b, int& R, int& C) { const int st = b / 1024, sb = b % 1024, swz = sb ^ (((sb >> 9) & 1) << 5); R = (st >> 1) * 16 + swz / 64; C = (st & 1) * 32 + (swz % 64) / 2; }
__host__ __device__ __forceinline__ int perm32(int rho) { const int n = rho >> 4, i = rho & 15; return 8 * (i >> 2) + 4 * n + (i & 3); }

struct Unit { int pm, pn; };
struct Gemm { const bf16_t* A; const bf16_t* Bt; int M, N, K; };

struct StaticOrder {
    int nM, nN, nwg, G, c;
    __host__ __device__ void init(int M, int N, int G_, int c_) { nM = M / BM; nN = N / BM; nwg = nM * nN; G = G_; c = c_; }
    __host__ __device__ bool next(int i, Unit& u) const {
        const long L = (long)i * G + c; if (L >= nwg) return false;
        int wgid = (int)L; { const int q = nwg / NXCD, xcd = wgid % NXCD, off = wgid / NXCD; wgid = xcd * q + off; }
        const int nig = WGM * nN, gid = wgid / nig, fm = gid * WGM, gsz = (nM - fm) < WGM ? (nM - fm) : WGM;
        u.pm = fm + ((wgid % nig) % gsz); u.pn = (wgid % nig) / gsz; return true;
    }
    __device__ __forceinline__ void a_ready(const Unit&) const {}
    __device__ __forceinline__ void done(const Unit&) const {}
};
typedef float f32x2_cv __attribute__((ext_vector_type(2)));
typedef __bf16 bf16x2_cv __attribute__((ext_vector_type(2)));
__device__ __forceinline__ unsigned cvt_pk_bf16(float lo, float hi) { const f32x2_cv v = {lo, hi}; const bf16x2_cv b = __builtin_convertvector(v, bf16x2_cv); return __builtin_bit_cast(unsigned, b); }
template <class Epi, class Sched, bool ALIGN_EPI = false, bool SP2 = false>
__device__ __forceinline__ void gemm_phase(PG8_LAS unsigned char* lds, const Gemm g, const Sched& S, const Epi& E) {
    int tid_o = (int)__builtin_amdgcn_mbcnt_hi(~0u, __builtin_amdgcn_mbcnt_lo(~0u, 0u)) | (__builtin_amdgcn_readfirstlane((int)threadIdx.x >> 6) << 6); asm volatile("" : "+v"(tid_o));
    const int tid = tid_o, wid = __builtin_amdgcn_readfirstlane(tid >> 6), lane = tid & 63, wr = wid >> 2, wc = wid & 3, fr = lane & 15, fq = lane >> 4;
    const int K = g.K, nt = K / BK;
    unsigned voffA[2], voffB[2];
#pragma unroll
    for (int i = 0; i < 2; ++i) { int R, C; stage_rc(tid * 16 + i * 8192, R, C); const int Rb = Epi::PERM ? ((R & ~31) + perm32(R & 31)) : R;
        voffA[i] = (unsigned)(R * K + C) * 2u; voffB[i] = (unsigned)(Rb * K + C) * 2u; }
    const size_t kstep = (size_t)(BK * 2);
    const size_t hstep = (size_t)HALF * K * 2;
    const size_t tstep = 2 * hstep;
    const unsigned ldsw = (unsigned)wid * 1024u;
    const int aoff = lds_byte(wr * 64 + fr, fq * 8), boff = lds_byte(wc * 32 + fr, fq * 8);
#define PG8_SA(b, h) (((b) * 2 + (h)) * HTB)
#define PG8_SB(b, h) ((4 + (b) * 2 + (h)) * HTB)
#define PG8_STAGE(bufoff, gbase, voff) do { _Pragma("unroll") for (int _i = 0; _i < 2; ++_i) \
        __builtin_amdgcn_global_load_lds((const unsigned*)((const char*)(gbase) + (voff)[_i]), (PG8_LAS unsigned*)(lds + (bufoff) + ldsw + _i * 8192), 16, 0, 0); } while (0)
#define PG8_LDA(dst, b, h) do { _Pragma("unroll") for (int m = 0; m < 4; ++m) _Pragma("unroll") for (int k = 0; k < 2; ++k) dst[m][k] = *(const PG8_LAS bf16x8*)(lds + PG8_SA(b, h) + aoff + m * 2048 + k * 1024); } while (0)
#define PG8_LDB(dst, b, h) do { _Pragma("unroll") for (int n = 0; n < 2; ++n) _Pragma("unroll") for (int k = 0; k < 2; ++k) dst[n][k] = *(const PG8_LAS bf16x8*)(lds + PG8_SB(b, h) + boff + n * 2048 + k * 1024); } while (0)
#define PG8_MMA(ai, bj, At, Bt) do { __builtin_amdgcn_s_setprio(1); _Pragma("unroll") for (int m = 0; m < 4; ++m) _Pragma("unroll") for (int n = 0; n < 2; ++n) _Pragma("unroll") for (int k = 0; k < 2; ++k) \
        acc[ai][bj][m][n] = __builtin_amdgcn_mfma_f32_16x16x32_bf16(Bt[n][k], At[m][k], acc[ai][bj][m][n], 0, 0, 0); __builtin_amdgcn_s_setprio(0); } while (0)
#define PG8_WAIT_V(n) asm volatile("s_waitcnt vmcnt(" #n ")" ::: "memory")
#define PG8_WAIT_L(n) asm volatile("s_waitcnt lgkmcnt(" #n ")" ::: "memory")
#define PG8_BAR __builtin_amdgcn_s_barrier()
#define PG8_SCHED __builtin_amdgcn_sched_barrier(0)
    Unit cur, nxt; int ui = 0;
    if (!S.next(0, cur)) return;
    f32x4 acc[2][2][4][2];
#pragma unroll
    for (int a = 0; a < 2; ++a)
#pragma unroll
        for (int b = 0; b < 2; ++b)
#pragma unroll
            for (int m = 0; m < 4; ++m)
#pragma unroll
                for (int n = 0; n < 2; ++n) acc[a][b][m][n] = (f32x4){0.f, 0.f, 0.f, 0.f};
    bf16x8 At[4][2], B0[2][2], B1[2][2];
    const char* cA = (const char*)g.A + (size_t)cur.pm * tstep; const char* cB = (const char*)g.Bt + (size_t)cur.pn * tstep;
    S.a_ready(cur);
    if constexpr (SP2) {
        PG8_STAGE(PG8_SB(0, 0), cB, voffB); PG8_STAGE(PG8_SB(0, 1), cB + hstep, voffB); PG8_STAGE(PG8_SA(0, 0), cA, voffA); PG8_STAGE(PG8_SA(0, 1), cA + hstep, voffA);
        if (wr == 1) PG8_BAR;
        PG8_WAIT_V(2); PG8_BAR;
        PG8_STAGE(PG8_SB(1, 0), cB + kstep, voffB); PG8_STAGE(PG8_SA(1, 0), cA + kstep, voffA); PG8_STAGE(PG8_SB(1, 1), cB + hstep + kstep, voffB);
        PG8_WAIT_V(6); PG8_BAR;
    } else {
        PG8_STAGE(PG8_SB(0, 0), cB, voffB); PG8_STAGE(PG8_SA(0, 0), cA, voffA); PG8_STAGE(PG8_SB(0, 1), cB + hstep, voffB); PG8_STAGE(PG8_SA(0, 1), cA + hstep, voffA);
        if (wr == 1) PG8_BAR;
        PG8_WAIT_V(4); PG8_BAR;
        PG8_STAGE(PG8_SB(1, 0), cB + kstep, voffB); PG8_STAGE(PG8_SA(1, 0), cA + kstep, voffA); PG8_STAGE(PG8_SB(1, 1), cB + hstep + kstep, voffB);
        PG8_WAIT_V(6); PG8_BAR;
    }
    for (;;) {
        const bool has_next = S.next(ui + 1, nxt);
        const char* nA = has_next ? (const char*)g.A + (size_t)nxt.pm * tstep : cA; const char* nB = has_next ? (const char*)g.Bt + (size_t)nxt.pn * tstep : cB;
        for (int t = 0; t < nt; t += 2) {
            const bool last = (t == nt - 2);
            const char* a1 = cA + (size_t)(t + 1) * kstep;
            const char* a2 = last ? nA : cA + (size_t)(t + 2) * kstep; const char* b2 = last ? nB : cB + (size_t)(t + 2) * kstep;
            const char* a3 = a2 + kstep; const char* b3 = b2 + kstep;
            if (last && has_next) S.a_ready(nxt);
            if constexpr (SP2) {
            PG8_LDB(B0, 0, 0); PG8_LDB(B1, 0, 1); PG8_SCHED; PG8_LDA(At, 0, 0); PG8_STAGE(PG8_SA(1, 1), a1 + hstep, voffA);
            PG8_WAIT_V(8); PG8_WAIT_L(0); PG8_BAR; PG8_MMA(0, 0, At, B0); PG8_MMA(0, 1, At, B1); PG8_BAR; PG8_SCHED;
            PG8_LDA(At, 0, 1); PG8_STAGE(PG8_SB(0, 0), b2, voffB); PG8_STAGE(PG8_SB(0, 1), b2 + hstep, voffB); PG8_STAGE(PG8_SA(0, 0), a2, voffA);
            PG8_WAIT_V(8); PG8_WAIT_L(0); PG8_BAR; PG8_MMA(1, 0, At, B0); PG8_MMA(1, 1, At, B1); PG8_BAR; PG8_SCHED;
            PG8_LDB(B0, 1, 0); PG8_LDB(B1, 1, 1); PG8_SCHED; PG8_LDA(At, 1, 0); PG8_STAGE(PG8_SA(0, 1), a2 + hstep, voffA);
            PG8_WAIT_V(8); PG8_WAIT_L(0); PG8_BAR; PG8_MMA(0, 0, At, B0); PG8_MMA(0, 1, At, B1); PG8_BAR; PG8_SCHED;
            PG8_LDA(At, 1, 1); PG8_STAGE(PG8_SB(1, 0), b3, voffB); PG8_STAGE(PG8_SB(1, 1), b3 + hstep, voffB); PG8_STAGE(PG8_SA(1, 0), a3, voffA);
            PG8_WAIT_V(8); PG8_WAIT_L(0); PG8_BAR; PG8_MMA(1, 0, At, B0); PG8_MMA(1, 1, At, B1); PG8_BAR; PG8_SCHED;
            } else {
            PG8_LDB(B0, 0, 0); PG8_SCHED; PG8_LDA(At, 0, 0); PG8_STAGE(PG8_SA(1, 1), a1 + hstep, voffA);
            PG8_WAIT_L(8); PG8_BAR; PG8_WAIT_L(0); PG8_MMA(0, 0, At, B0); PG8_BAR; PG8_SCHED;
            PG8_LDB(B1, 0, 1); PG8_STAGE(PG8_SB(0, 0), b2, voffB);
            PG8_BAR; PG8_WAIT_L(0); PG8_MMA(0, 1, At, B1); PG8_BAR;
            PG8_LDA(At, 0, 1); PG8_STAGE(PG8_SA(0, 0), a2, voffA);
            PG8_BAR; PG8_WAIT_L(0); PG8_MMA(1, 0, At, B0); PG8_BAR; PG8_SCHED;
            PG8_STAGE(PG8_SB(0, 1), b2 + hstep, voffB);
            PG8_WAIT_V(6); PG8_BAR; PG8_MMA(1, 1, At, B1); PG8_BAR;
            PG8_LDB(B0, 1, 0); PG8_SCHED; PG8_LDA(At, 1, 0); PG8_STAGE(PG8_SA(0, 1), a2 + hstep, voffA);
            PG8_WAIT_L(8); PG8_BAR; PG8_WAIT_L(0); PG8_MMA(0, 0, At, B0); PG8_BAR; PG8_SCHED;
            PG8_LDB(B1, 1, 1); PG8_STAGE(PG8_SB(1, 0), b3, voffB);
            PG8_BAR; PG8_WAIT_L(0); PG8_MMA(0, 1, At, B1); PG8_BAR;
            PG8_LDA(At, 1, 1); PG8_STAGE(PG8_SA(1, 0), a3, voffA);
            PG8_BAR; PG8_WAIT_L(0); PG8_MMA(1, 0, At, B0); PG8_BAR; PG8_SCHED;
            PG8_STAGE(PG8_SB(1, 1), b3 + hstep, voffB);
            PG8_WAIT_V(6); PG8_BAR; PG8_MMA(1, 1, At, B1); PG8_BAR;
            }
        }
        if constexpr (ALIGN_EPI) { if (wr == 0) PG8_BAR; }
        if constexpr (!Epi::AFTER_DRAIN) { E(acc, cur, wr, wc, fr, fq); S.done(cur); }
        if (!has_next) break;
#pragma unroll
        for (int a = 0; a < 2; ++a)
#pragma unroll
            for (int b = 0; b < 2; ++b)
#pragma unroll
                for (int m = 0; m < 4; ++m)
#pragma unroll
                    for (int n = 0; n < 2; ++n) acc[a][b][m][n] = (f32x4){0.f, 0.f, 0.f, 0.f};
        cur = nxt; cA = nA; cB = nB; ++ui;
        if constexpr (ALIGN_EPI) { if (wr == 1) PG8_BAR; }
    }
    PG8_WAIT_V(0);
    if constexpr (!ALIGN_EPI) { if (wr == 0) PG8_BAR; }
    PG8_BAR;
    if constexpr (Epi::AFTER_DRAIN) { E.fused(acc, cur, wr, wc, fr, fq, lds, wid, lane); S.done(cur); }
#undef PG8_SA
#undef PG8_SB
#undef PG8_STAGE
#undef PG8_LDA
#undef PG8_LDB
#undef PG8_MMA
#undef PG8_WAIT_V
#undef PG8_WAIT_L
#undef PG8_BAR
#undef PG8_SCHED
}
}

using pg8::bf16_t; using pg8::bf16x8; using pg8::f32x4; using pg8::u32x4; using pg8::Unit; using pg8::Gemm; using pg8::StaticOrder; using pg8::cvt_pk_bf16;
#define LAS __attribute__((address_space(3)))
typedef float f32x16 __attribute__((ext_vector_type(16)));
typedef unsigned u32x2 __attribute__((ext_vector_type(2)));

constexpr int DM = 1024, NB = 16, SEQ = 4096, DEPTH = 2, MTOT = NB * SEQ;
constexpr int NG = 2, GB = NB / NG, MG = GB * SEQ;
constexpr int IN_COLS = 7584, NIN = 7680, NQKV = 1792, KQKV = 384, FFH = 2816, NGU = 2 * FFH;
constexpr float EPS = 1e-6f;
constexpr float QSCALE = 0.10206207261596577f * 1.4426950408889634f;
constexpr float RKSCALE = 0.08838834764831845f;

constexpr size_t al256(size_t x) { return (x + 255) & ~(size_t)255; }
constexpr size_t WS_CTL = 0, CTL_BYTES = 32768;
constexpr size_t SZ_WIN = (size_t)NIN * DM * 2, SZ_WQKV = (size_t)NQKV * KQKV * 2, SZ_WMO = (size_t)DM * 512 * 2, SZ_WPW = (size_t)DM * 512 * 2,
                 SZ_WRO = (size_t)DM * DM * 2, SZ_WOUT = (size_t)DM * DM * 2, SZ_WGU = (size_t)NGU * DM * 2, SZ_WDN = (size_t)DM * FFH * 2;
constexpr size_t OFF_WIN = 0, OFF_WQKV = OFF_WIN + SZ_WIN, OFF_WMO = OFF_WQKV + al256(SZ_WQKV), OFF_WPW = OFF_WMO + SZ_WMO, OFF_WRO = OFF_WPW + SZ_WPW,
                 OFF_WOUT = OFF_WRO + SZ_WRO, OFF_WGU = OFF_WOUT + SZ_WOUT, OFF_WDN = OFF_WGU + SZ_WGU, WL_BYTES = al256(OFF_WDN + SZ_WDN);
constexpr size_t WS_W = 32768;
constexpr size_t WS_COSR = WS_W + DEPTH * WL_BYTES, WS_SINR = WS_COSR + (size_t)MTOT * 64 * 4, WS_COSM = WS_SINR + (size_t)MTOT * 64 * 4, WS_SINM = WS_COSM + (size_t)MTOT * 16 * 4;
constexpr size_t WS_XB = WS_SINM + (size_t)MTOT * 16 * 4;
constexpr size_t WS_CQKV = WS_XB + (size_t)MG * 1024 * 2;
constexpr size_t WS_KPE = WS_CQKV + (size_t)MG * 384 * 2;
constexpr size_t WS_CONVA = WS_KPE + (size_t)MG * 32 * 2;
constexpr size_t WS_RQ = WS_CONVA + (size_t)MG * 512 * 2;
constexpr size_t WS_RK = WS_RQ + (size_t)MG * 512 * 2;
constexpr size_t WS_RV = WS_RK + (size_t)MG * 512 * 2;
constexpr size_t WS_RG = WS_RV + (size_t)MG * 1024 * 2;
constexpr size_t WS_GATES = WS_RG + (size_t)MG * 1024 * 2;
constexpr size_t WS_Q = WS_GATES + (size_t)MG * 3072 * 2;
constexpr size_t WS_KN = WS_Q + (size_t)MG * 768 * 2;
constexpr size_t WS_VT = WS_KN + (size_t)MG * 512 * 2;
constexpr size_t WS_OMLA = WS_VT + (size_t)MG * 512 * 2;
constexpr size_t WS_CONVY = WS_OMLA + (size_t)MG * 512 * 2;
constexpr size_t WS_RETF = WS_CONVY + (size_t)MG * 512 * 2;
constexpr size_t WS_RETB = WS_RETF + (size_t)MG * 1024 * 2;
constexpr size_t WS_SSQ = WS_RETB + (size_t)MG * 1024 * 2;
constexpr size_t WS_F2 = WS_SSQ + (size_t)MG * 8 * 4;
constexpr size_t WS_END = WS_F2 + (size_t)MG * 1024 * 2;
static_assert(WS_END <= (size_t)1 << 30, "workspace map must fit 1 GiB");

constexpr int LDS_BYTES = 147456, LDS_MISC = 131072;

struct Params { const float* in[24]; float* out; unsigned char* ws; };
typedef const __attribute__((address_space(4))) unsigned char* kptr_t;
#define PIN(i) (*(const float* const __attribute__((address_space(4)))*)(kp + 8 * (i)))
#define POUT (*(float* const __attribute__((address_space(4)))*)(kp + 192))
#define PWS (*(unsigned char* const __attribute__((address_space(4)))*)(kp + 200))

__device__ __forceinline__ int otid() { int t = (int)__builtin_amdgcn_mbcnt_hi(~0u, __builtin_amdgcn_mbcnt_lo(~0u, 0u)) | (__builtin_amdgcn_readfirstlane((int)threadIdx.x >> 6) << 6); asm volatile("" : "+v"(t)); return t; }
__device__ __forceinline__ float bf_lo(unsigned w) { return __builtin_bit_cast(float, w << 16); }
__device__ __forceinline__ float bf_hi(unsigned w) { return __builtin_bit_cast(float, w & 0xffff0000u); }
__device__ __forceinline__ float bf2f(unsigned short h) { return __builtin_bit_cast(float, (unsigned)h << 16); }
__device__ __forceinline__ unsigned short f2bf(float f) { return (unsigned short)(cvt_pk_bf16(f, 0.f) & 0xffffu); }
__device__ __forceinline__ u32x4 pack8(f32x4 a, f32x4 b) { u32x4 w; w.x = cvt_pk_bf16(a[0], a[1]); w.y = cvt_pk_bf16(a[2], a[3]); w.z = cvt_pk_bf16(b[0], b[1]); w.w = cvt_pk_bf16(b[2], b[3]); return w; }
__device__ __forceinline__ void store8(bf16_t* p, f32x4 a, f32x4 b) { *(u32x4*)p = pack8(a, b); }
__device__ __forceinline__ void unpack8(u32x4 w, f32x4& a, f32x4& b) { a = (f32x4){bf_lo(w.x), bf_hi(w.x), bf_lo(w.y), bf_hi(w.y)}; b = (f32x4){bf_lo(w.z), bf_hi(w.z), bf_lo(w.w), bf_hi(w.w)}; }
__device__ __forceinline__ float sigm(float x) { return __builtin_amdgcn_rcpf(1.f + __builtin_amdgcn_exp2f(x * -1.4426950408889634f)); }
__device__ __forceinline__ f32x4 sigm4(f32x4 x) {
    const f32x4 t = x * -1.4426950408889634f;
    const f32x4 e = (f32x4){__builtin_amdgcn_exp2f(t[0]), __builtin_amdgcn_exp2f(t[1]), __builtin_amdgcn_exp2f(t[2]), __builtin_amdgcn_exp2f(t[3])};
    const f32x4 d = e + 1.0f;
    return (f32x4){__builtin_amdgcn_rcpf(d[0]), __builtin_amdgcn_rcpf(d[1]), __builtin_amdgcn_rcpf(d[2]), __builtin_amdgcn_rcpf(d[3])};
}
__device__ __forceinline__ float shx(float v, int o, int lane) { (void)lane; return __shfl_xor(v, o); }
__device__ __forceinline__ float wave_sum(float v, int lane) {
#pragma unroll
    for (int o = 1; o < 64; o <<= 1) v += shx(v, o, lane);
    return v;
}
__device__ __forceinline__ float dot4(f32x4 a) { return (a[0] * a[0] + a[1] * a[1]) + (a[2] * a[2] + a[3] * a[3]); }
__device__ __forceinline__ void rope8(f32x4& a, f32x4& b, f32x4 c, f32x4 s) {
    f32x4 ra, rb;
    ra[0] = a[0] * c[0] - a[1] * s[0]; ra[1] = a[1] * c[0] + a[0] * s[0];
    ra[2] = a[2] * c[1] - a[3] * s[1]; ra[3] = a[3] * c[1] + a[2] * s[1];
    rb[0] = b[0] * c[2] - b[1] * s[2]; rb[1] = b[1] * c[2] + b[0] * s[2];
    rb[2] = b[2] * c[3] - b[3] * s[3]; rb[3] = b[3] * c[3] + b[2] * s[3];
    a = ra; b = rb;
}

#define FOR_ROWS(...) _Pragma("unroll") for (int ai = 0; ai < 2; ++ai) _Pragma("unroll") for (int m = 0; m < 4; ++m) { \
    const int row = u.pm * 256 + ai * 128 + wr * 64 + m * 16 + fr; \
    f32x4 a0 = acc[ai][0][m][0], a1 = acc[ai][0][m][1], b0 = acc[ai][1][m][0], b1 = acc[ai][1][m][1]; __VA_ARGS__ __builtin_amdgcn_sched_barrier(0); }
struct EpiBase { static constexpr bool PERM = true, AFTER_DRAIN = false; };

struct EpiIn : EpiBase {
    bf16_t *cqkv, *kpe, *conva, *rq, *rk, *rv, *rg, *gates; float* ssq; const float *cosr, *sinr, *cosm, *sinm;
    __device__ __forceinline__ void operator()(const f32x4 (&acc)[2][2][4][2], const Unit& u, int wr, int wc, int fr_, int fq_) const {
        int fr = fr_, fq = fq_; asm volatile("" : "+v"(fr), "+v"(fq));
        const int pn = u.pn, cl = wc * 32 + 8 * fq;
        if (pn == 0) {
            FOR_ROWS(
                store8(cqkv + (size_t)row * 384 + cl, a0, a1); store8(cqkv + (size_t)row * 384 + 128 + cl, b0, b1);
                float s = (dot4(a0) + dot4(a1)) + (dot4(b0) + dot4(b1)); s += shx(s, 16, fr + 16 * fq); s += shx(s, 32, fr + 16 * fq);
                if (fq == 0) ssq[row * 8 + wc] = s;
            )
        } else if (pn == 1) {
            FOR_ROWS(
                store8(cqkv + (size_t)row * 384 + 256 + cl, a0, a1);
                float s = dot4(a0) + dot4(a1); s += shx(s, 16, fr + 16 * fq); s += shx(s, 32, fr + 16 * fq);
                if (fq == 0) ssq[row * 8 + 4 + wc] = s;
                if (wc == 0) { const f32x4 c = *(const f32x4*)(cosm + (size_t)row * 16 + 4 * fq), sn = *(const f32x4*)(sinm + (size_t)row * 16 + 4 * fq);
                    rope8(b0, b1, c, sn); store8(kpe + (size_t)row * 32 + cl, b0, b1); }
            )
        } else if (pn < 6) {
            const int t = pn - 2;
            FOR_ROWS( store8(conva + (size_t)row * 512 + t * 128 + cl, a0 * sigm4(b0), a1 * sigm4(b1)); )
        } else if (pn < 10) {
            const bool isk = pn >= 8; bf16_t* dst = isk ? rk : rq; const int h0 = (isk ? pn - 8 : pn - 6) * 2; const float sc = isk ? RKSCALE : 1.f;
            FOR_ROWS(
                const f32x4 c = *(const f32x4*)(cosr + (size_t)row * 64 + (cl >> 1)), sn = *(const f32x4*)(sinr + (size_t)row * 64 + (cl >> 1));
                rope8(a0, a1, c, sn); rope8(b0, b1, c, sn);
                store8(dst + (size_t)row * 512 + h0 * 128 + cl, a0 * sc, a1 * sc); store8(dst + (size_t)row * 512 + (h0 + 1) * 128 + cl, b0 * sc, b1 * sc);
            )
        } else if (pn < 14) {
            const int t = pn - 10;
            FOR_ROWS( store8(rv + (size_t)row * 1024 + t * 256 + cl, a0, a1); store8(rv + (size_t)row * 1024 + t * 256 + 128 + cl, b0, b1); )
        } else if (pn < 18) {
            const int t = pn - 14;
            FOR_ROWS( store8(rg + (size_t)row * 1024 + t * 256 + cl, a0 * sigm4(a0), a1 * sigm4(a1)); store8(rg + (size_t)row * 1024 + t * 256 + 128 + cl, b0 * sigm4(b0), b1 * sigm4(b1)); )
        } else {
            const int t = pn - 18;
            FOR_ROWS( store8(gates + (size_t)row * 3072 + t * 256 + cl, sigm4(a0), sigm4(a1)); store8(gates + (size_t)row * 3072 + t * 256 + 128 + cl, sigm4(b0), sigm4(b1)); )
        }
    }
};

__device__ __forceinline__ float ssq4(const float* p) { const f32x4 v = *(const f32x4*)p; return (v[0] + v[1]) + (v[2] + v[3]); }
struct EpiQKV : EpiBase {
    bf16_t *q, *kn, *vt; const float* ssq; const float *cosm, *sinm;
    __device__ __forceinline__ void operator()(const f32x4 (&acc)[2][2][4][2], const Unit& u, int wr, int wc, int fr_, int fq_) const {
        int fr = fr_, fq = fq_; asm volatile("" : "+v"(fr), "+v"(fq));
        const int pn = u.pn, cl = wc * 32 + 8 * fq;
        if (pn < 2) {
            FOR_ROWS( const float r = rsqrtf(ssq4(ssq + row * 8) * (1.f / 256.f) + EPS) * QSCALE;
                store8(q + (size_t)row * 768 + pn * 256 + cl, a0 * r, a1 * r); store8(q + (size_t)row * 768 + pn * 256 + 128 + cl, b0 * r, b1 * r); )
        } else if (pn == 2) {
            FOR_ROWS( const float r = rsqrtf(ssq4(ssq + row * 8) * (1.f / 256.f) + EPS) * QSCALE;
                const f32x4 c = *(const f32x4*)(cosm + (size_t)row * 16 + 4 * fq), sn = *(const f32x4*)(sinm + (size_t)row * 16 + 4 * fq);
                rope8(a0, a1, c, sn); rope8(b0, b1, c, sn);
                store8(q + (size_t)row * 768 + 512 + cl, a0 * r, a1 * r); store8(q + (size_t)row * 768 + 512 + 128 + cl, b0 * r, b1 * r); )
        } else {
            const int hA = (pn - 3) * 2;
            if (wc < 2) {
                FOR_ROWS( const float r = rsqrtf(ssq4(ssq + row * 8 + 4) * (1.f / 128.f) + EPS);
                    store8(kn + (size_t)row * 512 + hA * 64 + cl, a0 * r, a1 * r); store8(kn + (size_t)row * 512 + (hA + 1) * 64 + cl, b0 * r, b1 * r); )
            } else {
                const int d0 = cl - 64;
                FOR_ROWS( const float r = rsqrtf(ssq4(ssq + row * 8 + 4) * (1.f / 128.f) + EPS);
                    const int bl = row >> 12, s = row & 4095;
                    bf16_t* pa = vt + ((((size_t)bl * 64 + (s >> 6)) * 8 + (d0 >> 3)) * 8 + hA) * 512 + (s & 63);
                    _Pragma("unroll") for (int t = 0; t < 4; ++t) { pa[t * 64] = f2bf(a0[t] * r); pa[(t + 4) * 64] = f2bf(a1[t] * r);
                                                  pa[512 + t * 64] = f2bf(b0[t] * r); pa[512 + (t + 4) * 64] = f2bf(b1[t] * r); } )
            }
        }
    }
};

template <int MODE> struct EpiMerge : EpiBase {
    bf16_t* merged; const bf16_t* gates; int gi;
    __device__ __forceinline__ void operator()(const f32x4 (&acc)[2][2][4][2], const Unit& u, int wr, int wc, int fr_, int fq_) const {
        int fr = fr_, fq = fq_; asm volatile("" : "+v"(fr), "+v"(fq));
        const int cl = wc * 32 + 8 * fq, col = u.pn * 256 + cl;
        FOR_ROWS(
            f32x4 g0, g1, g2, g3; unpack8(*(const u32x4*)(gates + (size_t)row * 3072 + gi * 1024 + col), g0, g1); unpack8(*(const u32x4*)(gates + (size_t)row * 3072 + gi * 1024 + col + 128), g2, g3);
            a0 = a0 * g0; a1 = a1 * g1; b0 = b0 * g2; b1 = b1 * g3;
            if (MODE == 1) { f32x4 p0, p1, p2, p3; unpack8(*(const u32x4*)(merged + (size_t)row * 1024 + col), p0, p1); unpack8(*(const u32x4*)(merged + (size_t)row * 1024 + col + 128), p2, p3);
                a0 = a0 + p0; a1 = a1 + p1; b0 = b0 + p2; b1 = b1 + p3; }
            store8(merged + (size_t)row * 1024 + col, a0, a1); store8(merged + (size_t)row * 1024 + col + 128, b0, b1);
        )
    }
};

struct EpiPlain : EpiBase {
    bf16_t* o; int ldc;
    __device__ __forceinline__ void operator()(const f32x4 (&acc)[2][2][4][2], const Unit& u, int wr, int wc, int fr_, int fq_) const {
        int fr = fr_, fq = fq_; asm volatile("" : "+v"(fr), "+v"(fq));
        const int col = u.pn * 256 + wc * 32 + 8 * fq;
        FOR_ROWS( store8(o + (size_t)row * ldc + col, a0, a1); store8(o + (size_t)row * ldc + col + 128, b0, b1); )
    }
};

struct EpiSwiGLU : EpiBase {
    bf16_t* hid;
    __device__ __forceinline__ void operator()(const f32x4 (&acc)[2][2][4][2], const Unit& u, int wr, int wc, int fr_, int fq_) const {
        int fr = fr_, fq = fq_; asm volatile("" : "+v"(fr), "+v"(fq));
        const int col = u.pn * 128 + wc * 32 + 8 * fq;
        FOR_ROWS( store8(hid + (size_t)row * FFH + col, a0 * sigm4(a0) * b0, a1 * sigm4(a1) * b1); )
    }
};

__device__ __forceinline__ int srcmap_in(int n) {
    if (n < 384) return n;
    if (n < 416) { const int p = n - 384; return 384 + (p >> 1) + 16 * (p & 1); }
    if (n < 512) return -1;
    if (n < 1536) { const int t = (n - 512) >> 8, j = (n - 512) & 255; return j < 128 ? 416 + t * 128 + j : 416 + 512 + t * 128 + (j - 128); }
    if (n < 2560) { const int isk = n >= 2048, nn = (n - 1536) & 511, hh = nn >> 7, p = nn & 127; return (isk ? 1952 : 1440) + hh * 128 + (p >> 1) + 64 * (p & 1); }
    if (n < 3584) return 2464 + (n - 2560);
    if (n < 4608) return 3488 + (n - 3584);
    return 4512 + (n - 4608);
}
template <class F> __device__ __forceinline__ void transpose_w(F elem, int N, int K, bf16_t* WT, LAS float* scr, int gw, int nw, int lane) {
    const int nblk = N / 32, total = nblk * (K / 64);
    for (int item = gw; item < total; item += nw) {
        const int kb = item / nblk, nb = item % nblk, k0 = 64 * kb, n0 = 32 * nb;
        float ev[32];
#pragma unroll
        for (int i = 0; i < 32; ++i) ev[i] = elem(n0 + (lane & 31), k0 + 2 * i + (lane >> 5));
#pragma unroll
        for (int i = 0; i < 32; ++i) scr[(2 * i + (lane >> 5)) * 33 + (lane & 31)] = ev[i];
        asm volatile("s_waitcnt lgkmcnt(0)" ::: "memory");
        const int c = lane & 7;
#pragma unroll
        for (int j = 0; j < 4; ++j) { const int n = (lane >> 3) + 8 * j; const LAS float* s = scr + (8 * c) * 33 + n;
            u32x4 o; o.x = cvt_pk_bf16(s[0 * 33], s[1 * 33]); o.y = cvt_pk_bf16(s[2 * 33], s[3 * 33]); o.z = cvt_pk_bf16(s[4 * 33], s[5 * 33]); o.w = cvt_pk_bf16(s[6 * 33], s[7 * 33]);
            *(u32x4*)(WT + (size_t)(n0 + n) * K + k0 + 8 * c) = o; }
        asm volatile("s_waitcnt lgkmcnt(0)" ::: "memory");
    }
}

__device__ __forceinline__ void prologue(kptr_t kp, LAS unsigned char* lds, int gw, int nw, int wid, int lane, int l_lo = 0, int l_hi = DEPTH, bool tables = true) {
    unsigned char* const ws_ = PWS;
    LAS float* scr = (LAS float*)(lds + wid * (64 * 33 * 4));
    for (int l = l_lo; l < l_hi; ++l) {
        unsigned char* wl = ws_ + WS_W + (size_t)l * WL_BYTES;
        const float* w_in = PIN(6) + (size_t)l * DM * IN_COLS;
        transpose_w([=](int n, int k) { const int s = srcmap_in(n); return s < 0 ? 0.f : w_in[(size_t)k * IN_COLS + s]; }, NIN, DM, (bf16_t*)(wl + OFF_WIN), scr, gw, nw, lane);
        const float* qn = PIN(7) + l * 256; const float* wuq = PIN(8) + (size_t)l * 256 * 768; const float* kvn = PIN(9) + l * 128; const float* wukv = PIN(10) + (size_t)l * 128 * 1024;
        transpose_w([=](int n, int k) {
            if (n < 768) { if (k >= 256) return 0.f;
                int s; if (n < 512) s = (n >> 6) * 96 + (n & 63); else { const int hh = (n - 512) >> 5, p = (n - 512) & 31; s = hh * 96 + 64 + (p >> 1) + 16 * (p & 1); }
                return wuq[(size_t)k * 768 + s] * qn[k]; }
            if (k < 256) return 0.f;
            return wukv[(size_t)(k - 256) * 1024 + (n - 768)] * kvn[k - 256]; }, NQKV, KQKV, (bf16_t*)(wl + OFF_WQKV), scr, (gw + 300) % nw, nw, lane);
        const float* wmo = PIN(11) + (size_t)l * 512 * DM;
        transpose_w([=](int n, int k) { return wmo[(size_t)k * DM + n]; }, DM, 512, (bf16_t*)(wl + OFF_WMO), scr, (gw + 700) % nw, nw, lane);
        const float* wpw = PIN(16) + (size_t)l * 512 * DM;
        transpose_w([=](int n, int k) { return wpw[(size_t)k * DM + n]; }, DM, 512, (bf16_t*)(wl + OFF_WPW), scr, (gw + 1000) % nw, nw, lane);
        const float* wro = PIN(19) + (size_t)l * DM * DM;
        transpose_w([=](int n, int k) { return wro[(size_t)k * DM + n]; }, DM, DM, (bf16_t*)(wl + OFF_WRO), scr, (gw + 1300) % nw, nw, lane);
        const float* wout = PIN(20) + (size_t)l * DM * DM;
        transpose_w([=](int n, int k) { return wout[(size_t)k * DM + n]; }, DM, DM, (bf16_t*)(wl + OFF_WOUT), scr, (gw + 1800) % nw, nw, lane);
        const float* wg = PIN(21) + (size_t)l * DM * FFH; const float* wu = PIN(22) + (size_t)l * DM * FFH;
        transpose_w([=](int n, int k) { const int t = n >> 8, j = n & 255; return j < 128 ? wg[(size_t)k * FFH + t * 128 + j] : wu[(size_t)k * FFH + t * 128 + j - 128]; }, NGU, DM, (bf16_t*)(wl + OFF_WGU), scr, gw, nw, lane);
        const float* wd = PIN(23) + (size_t)l * FFH * DM;
        transpose_w([=](int n, int k) { return wd[(size_t)k * DM + n]; }, DM, FFH, (bf16_t*)(wl + OFF_WDN), scr, (gw + 500) % nw, nw, lane);
    }
    if (!tables) return;
    const int* pos = (const int*)PIN(1);
    float* cosr = (float*)(ws_ + WS_COSR); float* sinr = (float*)(ws_ + WS_SINR); float* cosm = (float*)(ws_ + WS_COSM); float* sinm = (float*)(ws_ + WS_SINM);
    const float invr = exp2f(-(float)lane * (13.287712379549449f / 64.f));
    const float invm = exp2f(-(float)(lane & 15) * (13.287712379549449f / 16.f));
    for (int t = gw; t < MTOT; t += nw) {
        const float pf = (float)pos[t];
        { const float ang = pf * invr; double r = (double)ang * 0.15915494309189535; r -= floor(r); const float rf = (float)r;
          cosr[(size_t)t * 64 + lane] = __builtin_amdgcn_cosf(rf); sinr[(size_t)t * 64 + lane] = __builtin_amdgcn_sinf(rf); }
        if (lane < 16) { const float ang = pf * invm; double r = (double)ang * 0.15915494309189535; r -= floor(r); const float rf = (float)r;
          cosm[(size_t)t * 16 + lane] = __builtin_amdgcn_cosf(rf); sinm[(size_t)t * 16 + lane] = __builtin_amdgcn_sinf(rf); }
    }
}

template <bool HASF, int NR, bool HASF2 = false>
__device__ __forceinline__ void rowpass_x_t(const float* xin, const bf16_t* f, const float* gpost, float* xout, const float* gnext, bf16_t* xb, int rows, int gw, int nw, int lane, const bf16_t* f2 = nullptr, const float* gpost2 = nullptr) {
    for (int row0 = gw; row0 < rows; row0 += NR * nw) {
        f32x4 v[NR][4]; u32x2 fw[NR][4]; u32x2 fw2[NR][4];
#pragma unroll
        for (int u = 0; u < NR; ++u)
#pragma unroll
            for (int j = 0; j < 4; ++j) { v[u][j] = __builtin_nontemporal_load((const f32x4*)(xin + (size_t)(row0 + u * nw) * DM + 4 * lane + 256 * j));
                if (HASF) fw[u][j] = __builtin_nontemporal_load((const u32x2*)(f + (size_t)(row0 + u * nw) * DM + 4 * lane + 256 * j));
                if (HASF2) fw2[u][j] = __builtin_nontemporal_load((const u32x2*)(f2 + (size_t)(row0 + u * nw) * DM + 4 * lane + 256 * j)); }
#pragma unroll
        for (int u = 0; u < NR; ++u) {
            const int row = row0 + u * nw;
            if (HASF) {
                f32x4 fv[4]; float ss = 0.f;
#pragma unroll
                for (int j = 0; j < 4; ++j) { const u32x2 w = fw[u][j]; fv[j] = (f32x4){bf_lo(w.x), bf_hi(w.x), bf_lo(w.y), bf_hi(w.y)}; ss += dot4(fv[j]); }
                const float r = rsqrtf(wave_sum(ss, lane) * (1.f / DM) + EPS);
#pragma unroll
                for (int j = 0; j < 4; ++j) { const f32x4 g = *(const f32x4*)(gpost + 4 * lane + 256 * j); v[u][j] = v[u][j] + fv[j] * r * g; }
            }
            if (HASF2) {
                f32x4 fv[4]; float ss = 0.f;
#pragma unroll
                for (int j = 0; j < 4; ++j) { const u32x2 w = fw2[u][j]; fv[j] = (f32x4){bf_lo(w.x), bf_hi(w.x), bf_lo(w.y), bf_hi(w.y)}; ss += dot4(fv[j]); }
                const float r = rsqrtf(wave_sum(ss, lane) * (1.f / DM) + EPS);
#pragma unroll
                for (int j = 0; j < 4; ++j) { const f32x4 g = *(const f32x4*)(gpost2 + 4 * lane + 256 * j); v[u][j] = v[u][j] + fv[j] * r * g; }
            }
            if (xout) {
#pragma unroll
                for (int j = 0; j < 4; ++j) __builtin_nontemporal_store(v[u][j], (f32x4*)(xout + (size_t)row * DM + 4 * lane + 256 * j));
            }
            if (xb) {
                float ss = 0.f;
#pragma unroll
                for (int j = 0; j < 4; ++j) ss += dot4(v[u][j]);
                const float r = rsqrtf(wave_sum(ss, lane) * (1.f / DM) + EPS);
#pragma unroll
                for (int j = 0; j < 4; ++j) { const f32x4 g = *(const f32x4*)(gnext + 4 * lane + 256 * j); const f32x4 y = v[u][j] * r * g;
                    u32x2 w; w.x = cvt_pk_bf16(y[0], y[1]); w.y = cvt_pk_bf16(y[2], y[3]); __builtin_nontemporal_store(w, (u32x2*)(xb + (size_t)row * DM + 4 * lane + 256 * j)); }
            }
        }
    }
}
__device__ __forceinline__ void rowpass_x(const float* xin, const bf16_t* f, const float* gpost, float* xout, const float* gnext, bf16_t* xb, float* ssqz, int rows, int gw, int nw, int lane, const bf16_t* f2 = nullptr, const float* gpost2 = nullptr) {
    (void)ssqz;
    if (f2) rowpass_x_t<true, 2, true>(xin, f, gpost, xout, gnext, xb, rows, gw, nw, lane, f2, gpost2);
    else if (f) rowpass_x_t<true, 4>(xin, f, gpost, xout, gnext, xb, rows, gw, nw, lane);
    else   rowpass_x_t<false, 4>(xin, f, gpost, xout, gnext, xb, rows, gw, nw, lane);
}
__device__ __forceinline__ void rowpass_ret(const bf16_t* retf, const bf16_t* retb, const bf16_t* rg, const float* gng, bf16_t* rety, int rows, int gw, int nw, int lane) {
    for (int row = gw; row < rows; row += nw) {
#pragma unroll
        for (int hh = 0; hh < 4; ++hh) {
            const size_t o = (size_t)row * 1024 + hh * 256 + 4 * lane;
            const u32x2 wf = __builtin_nontemporal_load((const u32x2*)(retf + o)), wb = __builtin_nontemporal_load((const u32x2*)(retb + o)), wg = __builtin_nontemporal_load((const u32x2*)(rg + o));
            f32x4 v = (f32x4){bf_lo(wf.x) + bf_lo(wb.x), bf_hi(wf.x) + bf_hi(wb.x), bf_lo(wf.y) + bf_lo(wb.y), bf_hi(wf.y) + bf_hi(wb.y)};
            const float mu = wave_sum((v[0] + v[1]) + (v[2] + v[3]), lane) * (1.f / 256.f);
            v = v - mu;
            const float rstd = rsqrtf(wave_sum(dot4(v), lane) * (1.f / 256.f) + EPS);
            const f32x4 g = *(const f32x4*)(gng + hh * 256 + 4 * lane);
            const f32x4 sg = (f32x4){bf_lo(wg.x), bf_hi(wg.x), bf_lo(wg.y), bf_hi(wg.y)};
            const f32x4 y = v * rstd * g * sg;
            u32x2 w; w.x = cvt_pk_bf16(y[0], y[1]); w.y = cvt_pk_bf16(y[2], y[3]); __builtin_nontemporal_store(w, (u32x2*)(rety + o));
        }
    }
}

__device__ __forceinline__ void lds_barrier() { asm volatile("s_waitcnt lgkmcnt(0)" ::: "memory"); __builtin_amdgcn_s_barrier(); asm volatile("" ::: "memory"); }
constexpr int AKP = 208, AVP = 136, ASTG = 64 * AKP + 64 * AVP;
__device__ __forceinline__ f32x16 mfma32(bf16x8 a, bf16x8 b, f32x16 c) { return __builtin_amdgcn_mfma_f32_32x32x16_bf16(a, b, c, 0, 0, 0); }
__device__ __forceinline__ f32x4 mfma16(bf16x8 a, bf16x8 b, f32x4 c) { return __builtin_amdgcn_mfma_f32_16x16x32_bf16(a, b, c, 0, 0, 0); }
__device__ __forceinline__ bf16x8 cat2(u32x2 lo, u32x2 hi) { u32x4 w; w.x = lo.x; w.y = lo.y; w.z = hi.x; w.w = hi.y; return __builtin_bit_cast(bf16x8, w); }

#define ATT_QK(Kb, d0, d1, iv) do { _Pragma("unroll") for (int i_ = 0; i_ < 16; ++i_) { d0[i_] = (iv); d1[i_] = (iv); } \
    _Pragma("unroll") for (int ks = 0; ks < 6; ++ks) { \
        const bf16x8 a0_ = *(const LAS bf16x8*)((Kb) + q32 * AKP + ks * 32 + hi * 16), a1_ = *(const LAS bf16x8*)((Kb) + (32 + q32) * AKP + ks * 32 + hi * 16); \
        d0 = mfma32(a0_, qf[ks], d0); d1 = mfma32(a1_, qf[ks], d1); } } while (0)
#define ATT_C(e) ((e) < 16 ? c0[(e) & 15] : c1[(e) & 15])
#define ATT_EXP2(c0, c1, e, SUB) do { if constexpr (MODE & 2) { } else if ((e) < 16) { c0[(e) & 15] = __builtin_amdgcn_exp2f(c0[(e) & 15] SUB); c0[((e) + 1) & 15] = __builtin_amdgcn_exp2f(c0[((e) + 1) & 15] SUB); ls2 = ls2 + (f32x2){c0[(e) & 15], c0[((e) + 1) & 15]}; } \
                              else { c1[(e) & 15] = __builtin_amdgcn_exp2f(c1[(e) & 15] SUB); c1[((e) + 1) & 15] = __builtin_amdgcn_exp2f(c1[((e) + 1) & 15] SUB); ls2 = ls2 + (f32x2){c1[(e) & 15], c1[((e) + 1) & 15]}; } } while (0)
#define ATT_VA(s2_, db_) cat2(*(const LAS u32x2*)(Vb + (q32 + 32 * (db_)) * AVP + (32 * ((s2_) >> 1) + 16 * ((s2_) & 1) + hi * 4) * 2), *(const LAS u32x2*)(Vb + (q32 + 32 * (db_)) * AVP + (32 * ((s2_) >> 1) + 16 * ((s2_) & 1) + hi * 4) * 2 + 16))
#define ATT_KF(ks_) (*(const LAS bf16x8*)(Kn + q32 * AKP + (ks_) * 32 + hi * 16))
#define ATT_KF2(ks_) (*(const LAS bf16x8*)(Kn + (32 + q32) * AKP + (ks_) * 32 + hi * 16))
#define ATT_ARM(c0, c1, n0, n1, SUB) do { \
        _Pragma("unroll") for (int i_ = 0; i_ < 16; ++i_) { n0[i_] = -m_init_n; n1[i_] = -m_init_n; } \
        bf16x8 ka0_ = ATT_KF(0), ka1_ = ATT_KF2(0); \
        _Pragma("unroll") for (int ks = 0; ks < 6; ++ks) { \
            bf16x8 kb0_ = ka0_, kb1_ = ka1_; \
            if (ks < 5) { kb0_ = ATT_KF(ks + 1); kb1_ = ATT_KF2(ks + 1); }        \
            if constexpr (!(MODE & 8)) { n0 = mfma32(ka0_, qf[ks], n0); n1 = mfma32(ka1_, qf[ks], n1); } \
            if (ks < 5) { ATT_EXP2(c0, c1, ks * 6 + 0, SUB); ATT_EXP2(c0, c1, ks * 6 + 2, SUB); ATT_EXP2(c0, c1, ks * 6 + 4, SUB); } else { ATT_EXP2(c0, c1, 30, SUB); } \
            __builtin_amdgcn_sched_barrier(0); ka0_ = kb0_; ka1_ = kb1_; } } while (0)
#define ATT_STEP(T, c0, c1, n0, n1, LK, LP, LV, WK, WP, WV, DOMAX) do { \
        const int t_ = (T), t3_ = t_ + 3 < SEQ / 64 ? t_ + 3 : SEQ / 64 - 1, t2_ = t_ + 2 < SEQ / 64 ? t_ + 2 : SEQ / 64 - 1;        \
        if constexpr (!(MODE & 1)) { LK = *(const u32x4*)(kn_p + (size_t)t3_ * 64 * 512); LP = *(const u32x4*)(kp_p + (size_t)t3_ * 64 * 32); LV = *(const u32x4*)(vt_p + (size_t)t2_ * 32768); } \
        LAS unsigned char* Kn = lds + ((t_ + 1) & 1) * ASTG; LAS unsigned char* Vb = lds + (t_ & 1) * ASTG + 64 * AKP; \
        const float m_init_n = m_now < -1e29f ? 0.f : m_now; \
        float mx = -1e30f;        \
        if (DOMAX) { mx = fmaxf(fmaxf(c0[0], c0[1]), c1[0]); \
        _Pragma("unroll") for (int i_ = 1; i_ < 16; i_ += 2) mx = fmaxf(fmaxf(mx, c0[i_]), (i_ + 1 < 16) ? c0[i_ + 1] : c0[i_]); \
        _Pragma("unroll") for (int i_ = 1; i_ < 16; i_ += 2) mx = fmaxf(fmaxf(mx, c1[i_]), (i_ + 1 < 16) ? c1[i_ + 1] : c1[i_]); \
        mx = fmaxf(mx, shx(mx, 32, lane)); } \
          \
          \
        const float d_ref = m_init - m_ref; \
        f32x2 ls2 = {0.f, 0.f}; \
        if (__builtin_amdgcn_ballot_w64(d_ref != 0.f) != 0) { \
            const float alpha = __builtin_amdgcn_exp2f(-d_ref); lrun *= alpha; \
            _Pragma("unroll") for (int i_ = 0; i_ < 16; ++i_) { o0[i_] *= alpha; o1[i_] *= alpha; } \
        } \
        m_ref = m_init; \
        { const float m_abs = m_init + mx; m_now = m_abs > m_now + 8.f ? m_abs : m_now; } \
        __builtin_amdgcn_sched_barrier(0); \
        ATT_ARM(c0, c1, n0, n1, ); \
        lrun += ls2.x + ls2.y; __builtin_amdgcn_sched_barrier(0); \
        bf16x8 va0_ = ATT_VA(0, 0), va1_ = ATT_VA(0, 1); \
        _Pragma("unroll") for (int s2 = 0; s2 < 4; ++s2) { \
            bf16x8 vb0_ = va0_, vb1_ = va1_; \
            if (s2 < 3) { vb0_ = ATT_VA(s2 + 1, 0); vb1_ = ATT_VA(s2 + 1, 1); } \
            const int i0 = 2 * (s2 & 1); u32x4 w_; \
            if (s2 < 2) { w_.x = cvt_pk_bf16(c0[i0 * 4 + 0], c0[i0 * 4 + 1]); w_.y = cvt_pk_bf16(c0[i0 * 4 + 2], c0[i0 * 4 + 3]); w_.z = cvt_pk_bf16(c0[i0 * 4 + 4], c0[i0 * 4 + 5]); w_.w = cvt_pk_bf16(c0[i0 * 4 + 6], c0[i0 * 4 + 7]); } \
            else        { w_.x = cvt_pk_bf16(c1[i0 * 4 + 0], c1[i0 * 4 + 1]); w_.y = cvt_pk_bf16(c1[i0 * 4 + 2], c1[i0 * 4 + 3]); w_.z = cvt_pk_bf16(c1[i0 * 4 + 4], c1[i0 * 4 + 5]); w_.w = cvt_pk_bf16(c1[i0 * 4 + 6], c1[i0 * 4 + 7]); } \
            const bf16x8 pb_ = __builtin_bit_cast(bf16x8, w_); \
            if constexpr (!(MODE & 4)) { o0 = mfma32(va0_, pb_, o0); o1 = mfma32(va1_, pb_, o1); } \
            __builtin_amdgcn_sched_barrier(0); va0_ = vb0_; va1_ = vb1_; } \
        __builtin_amdgcn_sched_barrier(0); \
        if constexpr (!(MODE & 1)) { LAS unsigned char* kw_ = lds + (t_ & 1) * ASTG; *(LAS u32x4*)(kw_ + wk) = WK; *(LAS u32x4*)(kw_ + wp) = WP; { LAS unsigned char* vw_ = lds + ((t_ + 1) & 1) * ASTG + wv; *(LAS u32x2*)vw_ = (u32x2){WV.x, WV.y}; *(LAS u32x2*)(vw_ + 8) = (u32x2){WV.z, WV.w}; } } \
        if constexpr (!(MODE & 16)) lds_barrier(); \
        m_init = m_init_n; \
    } while (0)
typedef float f32x2 __attribute__((ext_vector_type(2)));
template <int MODE = 0>
__device__ __forceinline__ void attn_unit(LAS unsigned char* lds, const bf16_t* Q, const bf16_t* KN, const bf16_t* KPE, const bf16_t* VT, bf16_t* O, int b, int h, int qb) {
    const int tid = otid(), wid = tid >> 6, lane = tid & 63, q32 = lane & 31, hi = lane >> 5;
    const size_t rowq = (size_t)b * SEQ + qb * 256 + wid * 32 + q32;
    bf16x8 qf[6];
#pragma unroll
    for (int ks = 0; ks < 4; ++ks) qf[ks] = *(const bf16x8*)(Q + rowq * 768 + h * 64 + ks * 16 + hi * 8);
#pragma unroll
    for (int ks = 0; ks < 2; ++ks) qf[4 + ks] = *(const bf16x8*)(Q + rowq * 768 + 512 + h * 32 + ks * 16 + hi * 8);
    f32x16 o0, o1;
#pragma unroll
    for (int i = 0; i < 16; ++i) { o0[i] = 0.f; o1[i] = 0.f; }
    float m_now = -1e30f, m_init = 0.f, m_ref = 0.f, lrun = 0.f;
    const int kkey = tid >> 3, kc = tid & 7, pkey = (tid & 255) >> 2, pc = tid & 3;
    const bf16_t* kn_p = KN + ((size_t)b * SEQ + kkey) * 512 + h * 64 + kc * 8;
    const bf16_t* kp_p = KPE + ((size_t)b * SEQ + pkey) * 32 + pc * 8;
    const bf16_t* vt_p = VT + ((((size_t)b * 64) * 8 + (kkey >> 3)) * 8 + h) * 512 + (kkey & 7) * 64 + kc * 8;
    const int wk = kkey * AKP + kc * 16, wp = pkey * AKP + 128 + pc * 16, wv = 64 * AKP + kkey * AVP + kc * 16;
    u32x4 rk, rp, rv;
    rk = *(const u32x4*)kn_p; rp = *(const u32x4*)kp_p; rv = *(const u32x4*)vt_p;
    *(LAS u32x4*)(lds + wk) = rk; *(LAS u32x4*)(lds + wp) = rp; *(LAS u32x2*)(lds + wv) = (u32x2){rv.x, rv.y}; *(LAS u32x2*)(lds + wv + 8) = (u32x2){rv.z, rv.w};
    rk = *(const u32x4*)(kn_p + (size_t)64 * 512); rp = *(const u32x4*)(kp_p + (size_t)64 * 32);
    *(LAS u32x4*)(lds + ASTG + wk) = rk; *(LAS u32x4*)(lds + ASTG + wp) = rp;
    u32x4 rk2 = *(const u32x4*)(kn_p + (size_t)2 * 64 * 512), rp2 = *(const u32x4*)(kp_p + (size_t)2 * 64 * 32), rv2 = *(const u32x4*)(vt_p + (size_t)32768);
    lds_barrier();
    f32x16 sa0, sa1, sb0, sb1;
    ATT_QK(lds, sa0, sa1, 0.f);
    lds_barrier();
#pragma unroll
    for (int i = 0; i < 16; ++i) { sb0[i] = 0.f; sb1[i] = 0.f; }
    for (int kt = 0; kt < SEQ / 64; kt += 2) {
        ATT_STEP(kt, sa0, sa1, sb0, sb1, rk, rp, rv, rk2, rp2, rv2, (kt & 7) == 0);
        ATT_STEP(kt + 1, sb0, sb1, sa0, sa1, rk2, rp2, rv2, rk, rp, rv, false);
    }
    const float lt = lrun + shx(lrun, 32, lane), inv = __builtin_amdgcn_rcpf(lt);
    bf16_t* op = O + rowq * 512 + h * 64 + hi * 4;
#pragma unroll
    for (int i = 0; i < 4; ++i) {
        u32x2 w; w.x = cvt_pk_bf16(o0[i * 4 + 0] * inv, o0[i * 4 + 1] * inv); w.y = cvt_pk_bf16(o0[i * 4 + 2] * inv, o0[i * 4 + 3] * inv); *(u32x2*)(op + 8 * i) = w;
        u32x2 w2; w2.x = cvt_pk_bf16(o1[i * 4 + 0] * inv, o1[i * 4 + 1] * inv); w2.y = cvt_pk_bf16(o1[i * 4 + 2] * inv, o1[i * 4 + 3] * inv); *(u32x2*)(op + 32 + 8 * i) = w2;
    }
}

__device__ __forceinline__ void conv_unit(LAS unsigned char* lds, const bf16_t* CA, const float* wdw, const float* bdw, const float* lng, const float* lnb, bf16_t* CY, int b, int tt) {
    const int tid = otid(), wid = tid >> 6, lane = tid & 63, t0 = tt * 32;
    {
        u32x4 rr[8]; f32x4 ww[8];
#pragma unroll
        for (int i = 0; i < 8; ++i) { const int id = tid + 512 * i, r = id >> 6, ck = id & 63, s = t0 + r - 15;
            rr[i] = (r < 62 && s >= 0 && s < SEQ) ? *(const u32x4*)(CA + ((size_t)b * SEQ + s) * 512 + ck * 8) : (u32x4){0u, 0u, 0u, 0u};
            ww[i] = id < 31 * 128 ? *(const f32x4*)(wdw + id * 4) : (f32x4){0.f, 0.f, 0.f, 0.f}; }
#pragma unroll
        for (int i = 0; i < 8; ++i) { const int id = tid + 512 * i; if (id < 62 * 64) { *(LAS u32x4*)(lds + id * 16) = rr[i]; *(LAS f32x4*)(lds + 65536 + id * 16) = ww[i]; } }
    }
    float acc[32]; const float bias = bdw[tid];
#pragma unroll
    for (int t = 0; t < 32; ++t) acc[t] = bias;
    __syncthreads();
    const LAS unsigned short* col = (const LAS unsigned short*)lds + tid;
    const LAS float* wcol = (const LAS float*)(lds + 65536) + tid;
#pragma unroll 1
    for (int k = 0; k < 31; ++k) {
        const float wk = wcol[k * 512];
        const LAS unsigned short* ck = col + k * 512;
#pragma unroll
        for (int t = 0; t < 32; ++t) acc[t] = __builtin_fmaf(wk, bf2f(ck[t * 512]), acc[t]);
    }
    __syncthreads();
    LAS float* yb = (LAS float*)lds;
#pragma unroll
    for (int t = 0; t < 32; ++t) yb[t * 512 + tid] = acc[t];
    __syncthreads();
    const f32x4 g0 = *(const f32x4*)(lng + lane * 8), g1 = *(const f32x4*)(lng + lane * 8 + 4), bb0 = *(const f32x4*)(lnb + lane * 8), bb1 = *(const f32x4*)(lnb + lane * 8 + 4);
#pragma unroll
    for (int j = 0; j < 4; ++j) {
        const int t = wid * 4 + j;
        f32x4 v0 = *(const LAS f32x4*)(yb + t * 512 + lane * 8), v1 = *(const LAS f32x4*)(yb + t * 512 + lane * 8 + 4);
        const float mu = wave_sum(((v0[0] + v0[1]) + (v0[2] + v0[3])) + ((v1[0] + v1[1]) + (v1[2] + v1[3])), lane) * (1.f / 512.f);
        v0 = v0 - mu; v1 = v1 - mu;
        const float rstd = rsqrtf(wave_sum(dot4(v0) + dot4(v1), lane) * (1.f / 512.f) + EPS);
        v0 = v0 * rstd * g0 + bb0; v1 = v1 * rstd * g1 + bb1;
        store8(CY + ((size_t)b * SEQ + t0 + t) * 512 + lane * 8, v0 * sigm4(v0), v1 * sigm4(v1));
    }
    __syncthreads();
}

__device__ __forceinline__ void ret_unit(LAS unsigned char* lds, const bf16_t* RQ, const bf16_t* RK, const bf16_t* RV, bf16_t* OUT, float lg2, int b, int h, int dir, int eh) {
    constexpr int KS = 0, KT = 32768, VTO = 65536, ST = 98304;
    const int tid = otid(), w = tid >> 6, lane = tid & 63, l16 = lane & 15, lq = lane >> 4;
    f32x4 st[8];
#pragma unroll
    for (int i = 0; i < 8; ++i) st[i] = (f32x4){0.f, 0.f, 0.f, 0.f};
    const float cdec = exp2f(lg2 * 128.f);
    const int tok0 = tid >> 4, dc = tid & 15;
    float kd[4];
#pragma unroll
    for (int i = 0; i < 4; ++i) { const int tok = tok0 + 32 * i; kd[i] = exp2f(lg2 * (float)(dir == 0 ? 127 - tok : tok)); }
    const int qloc = 16 * w + l16;
    const float cf = exp2f(lg2 * (float)(dir == 0 ? qloc + 1 : 128 - qloc));
    const int sw = l16 ^ (l16 >> 3);
    const unsigned rb16_0 = l16 * 256 + (((lq ^ sw) & 15) << 4);
    const unsigned rb8_0 = l16 * 256 + ((((lq >> 1) ^ sw) & 15) << 4) + (lq & 1) * 8;
    const unsigned wbK_0 = tok0 * 256 + (((dc ^ (tok0 & 15) ^ (tok0 >> 3)) & 15) << 4);
    const unsigned wbT_0 = dc * 2048 + ((((tok0 >> 3) ^ ((dc & 1) * 8) ^ dc) & 15) << 4) + (tok0 & 7) * 2;
    const unsigned wbS_0 = l16 * 256 + ((((2 * w) ^ (lq >> 1) ^ sw) & 15) << 4) + (lq & 1) * 8;
    u32x4 kreg[4], vreg[4]; bf16x8 qn[4];
    {
        const int c = dir == 0 ? 0 : 31; const size_t row0 = (size_t)b * SEQ + c * 128;
#pragma unroll
        for (int i = 0; i < 4; ++i) { kreg[i] = *(const u32x4*)(RK + (row0 + tok0 + 32 * i) * 512 + h * 128 + dc * 8); vreg[i] = *(const u32x4*)(RV + (row0 + tok0 + 32 * i) * 1024 + h * 256 + eh * 128 + dc * 8); }
#pragma unroll
        for (int ks = 0; ks < 4; ++ks) qn[ks] = *(const bf16x8*)(RQ + (row0 + qloc) * 512 + h * 128 + 32 * ks + lq * 8);
    }
    for (int it = 0; it < 32; ++it) {
        const int c = dir == 0 ? it : 31 - it; const size_t row0 = (size_t)b * SEQ + c * 128;
        unsigned rb16 = rb16_0, rb8 = rb8_0, wbK = wbK_0, wbT = wbT_0, wbS = wbS_0;
        asm volatile("" : "+v"(rb16), "+v"(rb8), "+v"(wbK), "+v"(wbT), "+v"(wbS));
#define R16(tile, blk, cc) (*(const LAS bf16x8*)(lds + (tile) + (blk) * 4096 + (rb16 ^ ((((cc)) & 15) << 4))))
#define R8(tile, blk, cc) (*(const LAS u32x2*)(lds + (tile) + (blk) * 4096 + (rb8 ^ ((((cc)) & 15) << 4))))
#pragma unroll
        for (int i = 0; i < 4; ++i) {
            *(LAS u32x4*)(lds + KS + i * 8192 + (wbK ^ ((4 * i) << 4))) = kreg[i];
            const unsigned kw[4] = {kreg[i].x, kreg[i].y, kreg[i].z, kreg[i].w}, vw[4] = {vreg[i].x, vreg[i].y, vreg[i].z, vreg[i].w};
#pragma unroll
            for (int jj = 0; jj < 8; ++jj) {
                const unsigned kwv = kw[jj >> 1], vwv = vw[jj >> 1];
                const float kf = ((jj & 1) ? bf_hi(kwv) : bf_lo(kwv)) * kd[i];
                const unsigned ad = jj * 256 + (wbT ^ (((4 * i) ^ jj) << 4));
                *(LAS unsigned short*)(lds + KT + ad) = f2bf(kf);
                *(LAS unsigned short*)(lds + VTO + ad) = (unsigned short)((jj & 1) ? (vwv >> 16) : (vwv & 0xffffu));
            }
        }
#pragma unroll
        for (int eb = 0; eb < 8; ++eb) { u32x2 wv; wv.x = cvt_pk_bf16(st[eb][0], st[eb][1]); wv.y = cvt_pk_bf16(st[eb][2], st[eb][3]); *(LAS u32x2*)(lds + ST + eb * 4096 + (wbS ^ ((2 * eb) << 4))) = wv; }
        bf16x8 qf[4];
#pragma unroll
        for (int ks = 0; ks < 4; ++ks) qf[ks] = qn[ks];
        __syncthreads();
        if (it + 1 < 32) {
            const int cn = dir == 0 ? it + 1 : 30 - it; const size_t rn = (size_t)b * SEQ + cn * 128;
#pragma unroll
            for (int i = 0; i < 4; ++i) { kreg[i] = *(const u32x4*)(RK + (rn + tok0 + 32 * i) * 512 + h * 128 + dc * 8); vreg[i] = *(const u32x4*)(RV + (rn + tok0 + 32 * i) * 1024 + h * 256 + eh * 128 + dc * 8); }
#pragma unroll
            for (int ks = 0; ks < 4; ++ks) qn[ks] = *(const bf16x8*)(RQ + (rn + qloc) * 512 + h * 128 + 32 * ks + lq * 8);
        }
        bf16x8 pb[4];
#pragma unroll
        for (int s = 0; s < 4; ++s) {
            f32x4 sc[2];
#pragma unroll
            for (int x = 0; x < 2; ++x) {
                const int kb = 2 * s + x; f32x4 a4 = (f32x4){0.f, 0.f, 0.f, 0.f};
#pragma unroll
                for (int ks = 0; ks < 4; ++ks) a4 = mfma16(R16(KS, kb, (4 * ks) ^ (2 * kb)), qf[ks], a4);
#pragma unroll
                for (int j = 0; j < 4; ++j) { const int k = 16 * kb + lq * 4 + j; const int df = dir == 0 ? qloc - k : k - qloc; const bool on = dir == 0 ? df >= 0 : df > 0;
                    a4[j] = on ? a4[j] * __builtin_amdgcn_exp2f(lg2 * (float)df) : 0.f; }
                sc[x] = a4;
            }
            pb[s] = __builtin_bit_cast(bf16x8, pack8(sc[0], sc[1]));
        }
        bf16_t* op = OUT + (row0 + qloc) * 1024 + h * 256 + eh * 128 + lq * 4;
#pragma unroll
        for (int eb = 0; eb < 8; ++eb) {
            f32x4 a4 = (f32x4){0.f, 0.f, 0.f, 0.f};
#pragma unroll
            for (int ks = 0; ks < 4; ++ks) a4 = mfma16(R16(ST, eb, (4 * ks) ^ (2 * eb)), qf[ks], a4);
            a4 = a4 * cf;
#pragma unroll
            for (int s = 0; s < 4; ++s) {
                const bf16x8 A = cat2(R8(VTO, eb, (4 * s) ^ (2 * eb)), R8(VTO, eb, (4 * s) ^ 2 ^ (2 * eb)));
                a4 = mfma16(A, pb[s], a4);
            }
            u32x2 wv; wv.x = cvt_pk_bf16(a4[0], a4[1]); wv.y = cvt_pk_bf16(a4[2], a4[3]); *(u32x2*)(op + 16 * eb) = wv;
        }
        bf16x8 ka[4];
#pragma unroll
        for (int s = 0; s < 4; ++s) ka[s] = R16(KT, w, (4 * s) ^ (2 * w));
#pragma unroll
        for (int eb = 0; eb < 8; ++eb) {
            f32x4 a4 = st[eb] * cdec;
#pragma unroll
            for (int s = 0; s < 4; ++s) a4 = mfma16(ka[s], R16(VTO, eb, (4 * s) ^ (2 * eb)), a4);
            st[eb] = a4;
        }
        __syncthreads();
#undef R16
#undef R8
    }
}

#define XB_TMO      128
#define XB_XCNT(j)  (256  + 64 * (j))
#define XB_XSUB(j)  (1280 + 64 * (j))
#define XB_XGEN(j)  (2304 + 64 * (j))
#define XB_TOP      3328
#define XB_TOPGEN   3392
#define XB_SPIN_CAP (1u << 18)
__device__ __forceinline__ unsigned xb_ld(unsigned* p)              { return __hip_atomic_load(p, __ATOMIC_RELAXED, __HIP_MEMORY_SCOPE_AGENT); }
__device__ __forceinline__ unsigned xb_add(unsigned* p, unsigned v) { return __hip_atomic_fetch_add(p, v, __ATOMIC_RELAXED, __HIP_MEMORY_SCOPE_AGENT); }
__device__ __forceinline__ unsigned xb_xcc_id() { return (unsigned)__builtin_amdgcn_s_getreg((3 << 11) | 20) & 0xFu; }
#define XB_SPIN(cond, bar) do { unsigned _sp = 0; while (cond) { __builtin_amdgcn_s_sleep(1); \
    if ((++_sp & 255u) == 0u) { if (xb_ld(&(bar)[XB_TMO])) break; if (_sp > XB_SPIN_CAP) { atomicAdd(&(bar)[XB_TMO], 1u); break; } } } } while (0)
__device__ __forceinline__ void xcd_barrier_complete(unsigned* bar, unsigned x, unsigned G, unsigned& nloc, unsigned& nx) {
    unsigned sum, cnt, mine, sp = 0u;
    for (;;) {
        sum = 0u; cnt = 0u; mine = 0u;
#pragma unroll
        for (unsigned j = 0; j < 16; ++j) { const unsigned c = xb_ld(&bar[XB_XCNT(j)]); sum += c; cnt += (c > 0u) ? 1u : 0u; mine = (j == x) ? c : mine; }
        if (sum == G) break;
        __builtin_amdgcn_s_sleep(1);
        if ((++sp & 255u) == 0u) { if (xb_ld(&bar[XB_TMO])) break; if (sp > XB_SPIN_CAP) { atomicAdd(&bar[XB_TMO], 1u); break; } }
    }
    nloc = mine > 0u ? mine : 1u; nx = cnt > 0u ? cnt : 1u;
}
__device__ __forceinline__ void xcd_barrier(unsigned* bar, volatile LAS unsigned* st, unsigned G, int tid) {
    asm volatile("s_waitcnt vmcnt(0)" ::: "memory");
    __syncthreads();
    if (tid == 0) {
        __builtin_amdgcn_s_waitcnt(0);
        const unsigned x = xb_xcc_id();
        unsigned nloc = st[0], nx = st[1];
        if (nloc == 0u) { xcd_barrier_complete(bar, x, G, nloc, nx); st[0] = nloc; st[1] = nx; }
        const unsigned old = xb_add(&bar[XB_XSUB(x)], 1u);
        const unsigned gen = old / nloc;
        if (old + 1u == (gen + 1u) * nloc) {
            __builtin_amdgcn_fence(__ATOMIC_RELEASE, "agent");
            asm volatile("s_waitcnt vmcnt(0)" ::: "memory");
            const unsigned og = xb_add(&bar[XB_TOP], 1u);
            const unsigned tg = og / nx;
            if (og + 1u == (tg + 1u) * nx) xb_add(&bar[XB_TOPGEN], 1u);
            else XB_SPIN(xb_ld(&bar[XB_TOPGEN]) == tg, bar);
            __builtin_amdgcn_fence(__ATOMIC_ACQUIRE, "agent");
            xb_add(&bar[XB_XGEN(x)], 1u);
            asm volatile("s_waitcnt vmcnt(0)" ::: "memory");
        } else {
            XB_SPIN(xb_ld(&bar[XB_XGEN(x)]) == gen, bar);
            __builtin_amdgcn_fence(__ATOMIC_ACQUIRE, "agent");
            asm volatile("s_waitcnt vmcnt(0)" ::: "memory");
        }
    }
    __syncthreads();
}
#define WSP(T, off) ((T*)(ws + (off)))
__global__ void __launch_bounds__(512, 2) fwd_megakernel(Params P) {
    extern __shared__ __attribute__((aligned(16))) unsigned char lds_raw[];
    LAS unsigned char* lds = (LAS unsigned char*)lds_raw;
    cg::grid_group grid = cg::this_grid();
#ifdef REPEAT_K
    constexpr int NPL = 11;
#else
    constexpr int NPL = 10;
#endif
    constexpr int NPH = 1 + NG * (1 + DEPTH * NPL);
    {
        volatile LAS unsigned* st0 = (volatile LAS unsigned*)(lds + LDS_MISC + 16);
        if (threadIdx.x == 0) { st0[0] = 0u; st0[1] = 0u; kptr_t kp = (kptr_t)__builtin_amdgcn_kernarg_segment_ptr(); (void)xb_add((unsigned*)(PWS + WS_CTL) + 2048 + XB_XCNT(xb_xcc_id()), 1u); }
        __syncthreads();
    }
    grid.sync();
    for (int ph = 0; ph < NPH; ++ph) {
        int G = (int)gridDim.x, bid = (int)blockIdx.x; asm volatile("" : "+s"(G), "+s"(bid));
        const int nw = G * 8;
        const int tid = otid(), wid = tid >> 6, lane = tid & 63, gw = bid * 8 + wid;
        kptr_t kp = (kptr_t)__builtin_amdgcn_kernarg_segment_ptr(); asm volatile("" : "+s"(kp));
        unsigned char* const ws = PWS;
        if (ph == 0) {
#ifndef NO_PRO
            prologue(kp, lds, gw, nw, wid, lane, 0, 1, true);
#endif
#ifdef PRO_X
            __syncthreads(); prologue(kp, lds, gw, nw, wid, lane);
#endif
        } else {
            const int qq = ph - 1, g = qq / (1 + DEPTH * NPL), r = qq % (1 + DEPTH * NPL);
            const size_t tokoff = (size_t)g * MG;
            const float* xg = PIN(0) + tokoff * DM; float* og = POUT + tokoff * DM;
            if (r == 0) {
                rowpass_x(xg, nullptr, nullptr, nullptr, PIN(2), WSP(bf16_t, WS_XB), WSP(float, WS_SSQ), MG, gw, nw, lane);
            } else {
#ifdef REPEAT_K
                const int l = (r - 1) / NPL, kp = (r - 1) % NPL, k = kp > REPEAT_K ? kp - 1 : kp, rep = kp == REPEAT_K + 1;
#else
                const int l = (r - 1) / NPL, k = (r - 1) % NPL; constexpr int rep = 0;
#endif
                const unsigned char* wl = ws + WS_W + (size_t)l * WL_BYTES;
                StaticOrder so;
                switch (k) {
                case 0: {
                    EpiIn e; e.cqkv = WSP(bf16_t, WS_CQKV); e.kpe = WSP(bf16_t, WS_KPE); e.conva = WSP(bf16_t, WS_CONVA); e.rq = WSP(bf16_t, WS_RQ); e.rk = WSP(bf16_t, WS_RK); e.rv = WSP(bf16_t, WS_RV);
                    e.rg = WSP(bf16_t, WS_RG); e.gates = WSP(bf16_t, WS_GATES); e.ssq = WSP(float, WS_SSQ);
                    e.cosr = WSP(const float, WS_COSR) + tokoff * 64; e.sinr = WSP(const float, WS_SINR) + tokoff * 64; e.cosm = WSP(const float, WS_COSM) + tokoff * 16; e.sinm = WSP(const float, WS_SINM) + tokoff * 16;
                    Gemm gm{WSP(const bf16_t, WS_XB), (const bf16_t*)(wl + OFF_WIN), MG, NIN, DM}; so.init(MG, NIN, G, bid); pg8::gemm_phase<EpiIn, StaticOrder, true, true>(lds, gm, so, e);
#ifdef TWICE_IN
                    __syncthreads(); pg8::gemm_phase<EpiIn, StaticOrder, true, true>(lds, gm, so, e);
#endif
                } break;
                case 1: {
                    EpiQKV e; e.q = WSP(bf16_t, WS_Q); e.kn = WSP(bf16_t, WS_KN); e.vt = WSP(bf16_t, WS_VT); e.ssq = WSP(const float, WS_SSQ); e.cosm = WSP(const float, WS_COSM) + tokoff * 16; e.sinm = WSP(const float, WS_SINM) + tokoff * 16;
                    int kq = KQKV; asm volatile("" : "+s"(kq));
                    Gemm gm{WSP(const bf16_t, WS_CQKV), (const bf16_t*)(wl + OFF_WQKV), MG, NQKV, kq}; so.init(MG, NQKV, G, bid); pg8::gemm_phase<EpiQKV, StaticOrder, true, true>(lds, gm, so, e);
                } break;
                case 2: {
                    #ifndef RET_X
#define RET_X 1
#endif
#ifndef ATT_X
#define ATT_X 1
#endif
#ifndef CONV_X
#define CONV_X 1
#endif
                    constexpr int NRET1 = GB * 4 * 2 * 2, NATT1 = GB * 8 * (SEQ / 256), NRET = NRET1 * RET_X, NATT = NATT1 * ATT_X, NCONV1 = GB * (SEQ / 32), NCONV = NCONV1 * CONV_X, NTOT = NRET + NATT + NCONV;
                    constexpr int NPRO = 256;
                    unsigned* ctr = WSP(unsigned, WS_CTL) + (g * DEPTH + l) + rep * 16;
                    volatile LAS unsigned* uw = (volatile LAS unsigned*)(lds + LDS_MISC);
                    for (;;) {
                        __syncthreads();
                        if (tid == 0) *uw = atomicAdd(ctr, 1u);
                        __syncthreads();
                        const int uidx = (int)*uw;
                        const int npro = (g == 0 && l == 0) ? NPRO : 0;
                        if (uidx >= NTOT + npro) break;
                        if (uidx >= NTOT) { prologue(kp, lds, (uidx - NTOT) * 8 + wid, NPRO * 8, wid, lane, 1, DEPTH, false); continue; }
                        if (uidx < NRET) {
#ifndef NO_RET
                            const int u1 = uidx % NRET1, eh = u1 & 1, dir = (u1 >> 1) & 1, hh = (u1 >> 2) & 3, b = u1 >> 4;
                            const float lgt = PIN(17)[l * 8 + dir * 4 + hh];
                            const float lsg = fminf(lgt, 0.f) - log1pf(expf(-fabsf(lgt)));
                            ret_unit(lds, WSP(const bf16_t, WS_RQ), WSP(const bf16_t, WS_RK), WSP(const bf16_t, WS_RV), dir == 0 ? WSP(bf16_t, WS_RETF) : WSP(bf16_t, WS_RETB), lsg * 1.4426950408889634f, b, hh, dir, eh);
#endif
                        } else if (uidx < NRET + NATT) {
                            const int v = (uidx - NRET) % NATT1, qb = v & 15, hh = (v >> 4) & 7, b = v >> 7;
#ifdef ATT_PROBE
                            if (uidx - NRET >= NATT1) attn_unit<ATT_PROBE>(lds, WSP(const bf16_t, WS_Q), WSP(const bf16_t, WS_KN), WSP(const bf16_t, WS_KPE), WSP(const bf16_t, WS_VT), (bf16_t*)(ws + WS_F2), b, hh, qb); else
#endif
                            attn_unit<0>(lds, WSP(const bf16_t, WS_Q), WSP(const bf16_t, WS_KN), WSP(const bf16_t, WS_KPE), WSP(const bf16_t, WS_VT), WSP(bf16_t, WS_OMLA), b, hh, qb);
                        } else {
                            const int v = (uidx - NRET - NATT) % NCONV1, tt = v & 127, b = v >> 7;
#ifndef NO_CONV
                            conv_unit(lds, WSP(const bf16_t, WS_CONVA), PIN(12) + l * 31 * 512, PIN(13) + l * 512, PIN(14) + l * 512, PIN(15) + l * 512, WSP(bf16_t, WS_CONVY), b, tt);
#endif
                        }
                    }
                } break;
                case 3:
                    rowpass_ret(WSP(const bf16_t, WS_RETF), WSP(const bf16_t, WS_RETB), WSP(const bf16_t, WS_RG), PIN(18) + l * 1024, WSP(bf16_t, WS_XB), MG, gw, nw, lane);
#ifdef RP_X
                    rowpass_ret(WSP(const bf16_t, WS_RETF), WSP(const bf16_t, WS_RETB), WSP(const bf16_t, WS_RG), PIN(18) + l * 1024, WSP(bf16_t, WS_XB), MG, gw, nw, lane);
#endif
                    break;
                case 4: {
                    so.init(MG, DM, G, bid);
                    { EpiMerge<0> e0; e0.merged = WSP(bf16_t, WS_RV); e0.gates = WSP(const bf16_t, WS_GATES); e0.gi = 0; Gemm gm{WSP(const bf16_t, WS_OMLA), (const bf16_t*)(wl + OFF_WMO), MG, DM, 512}; pg8::gemm_phase<EpiMerge<0>, StaticOrder, true, true>(lds, gm, so, e0); }
                    { EpiMerge<1> e1; e1.merged = WSP(bf16_t, WS_RV); e1.gates = WSP(const bf16_t, WS_GATES); e1.gi = 1; Gemm gm{WSP(const bf16_t, WS_CONVY), (const bf16_t*)(wl + OFF_WPW), MG, DM, 512}; pg8::gemm_phase<EpiMerge<1>, StaticOrder, true, true>(lds, gm, so, e1); }
                    { EpiMerge<1> e2; e2.merged = WSP(bf16_t, WS_RV); e2.gates = WSP(const bf16_t, WS_GATES); e2.gi = 2; Gemm gm{WSP(const bf16_t, WS_XB), (const bf16_t*)(wl + OFF_WRO), MG, DM, DM}; pg8::gemm_phase<EpiMerge<1>, StaticOrder, true, true>(lds, gm, so, e2); }
                } break;
                case 5: {
                    EpiPlain e; e.o = WSP(bf16_t, WS_RG); e.ldc = DM; Gemm gm{WSP(const bf16_t, WS_RV), (const bf16_t*)(wl + OFF_WOUT), MG, DM, DM}; so.init(MG, DM, G, bid); pg8::gemm_phase<EpiPlain, StaticOrder, true, true>(lds, gm, so, e);
                } break;
                case 6:
                    rowpass_x(l == 0 ? xg : og, WSP(const bf16_t, WS_RG), PIN(3) + l * DM, nullptr, PIN(4) + l * DM, WSP(bf16_t, WS_XB), nullptr, MG, gw, nw, lane);
                    break;
                case 7: {
                    EpiSwiGLU e; e.hid = WSP(bf16_t, WS_GATES); Gemm gm{WSP(const bf16_t, WS_XB), (const bf16_t*)(wl + OFF_WGU), MG, NGU, DM}; so.init(MG, NGU, G, bid); pg8::gemm_phase<EpiSwiGLU, StaticOrder, true, true>(lds, gm, so, e);
#ifdef TWICE_UP
                    __syncthreads(); pg8::gemm_phase<EpiSwiGLU, StaticOrder, true, true>(lds, gm, so, e);
#endif
                } break;
                case 8: {
                    EpiPlain e; e.o = WSP(bf16_t, WS_F2); e.ldc = DM; Gemm gm{WSP(const bf16_t, WS_GATES), (const bf16_t*)(wl + OFF_WDN), MG, DM, FFH}; so.init(MG, DM, G, bid); pg8::gemm_phase<EpiPlain, StaticOrder, true, true>(lds, gm, so, e);
                } break;
                default:
                    rowpass_x(l == 0 ? xg : og, WSP(const bf16_t, WS_RG), PIN(3) + l * DM, og, l + 1 < DEPTH ? PIN(2) + (l + 1) * DM : nullptr, l + 1 < DEPTH ? WSP(bf16_t, WS_XB) : nullptr, nullptr, MG, gw, nw, lane, WSP(const bf16_t, WS_F2), PIN(5) + l * DM);
                    break;
                }
            }
        }
        xcd_barrier(WSP(unsigned, WS_CTL) + 2048, (volatile LAS unsigned*)(lds + LDS_MISC + 16), (unsigned)G, tid);
#ifdef SYNC_X
        xcd_barrier(WSP(unsigned, WS_CTL) + 2048, (volatile LAS unsigned*)(lds + LDS_MISC + 16), (unsigned)G, tid); xcd_barrier(WSP(unsigned, WS_CTL) + 2048, (volatile LAS unsigned*)(lds + LDS_MISC + 16), (unsigned)G, tid);
#endif
#ifdef DIAG_STOP
        if (ph == DIAG_STOP) {
            const unsigned short* da = (const unsigned short*)(ws + DIAG_A); const unsigned short* db = (const unsigned short*)(ws + DIAG_B); float* o = POUT;
            for (size_t i = (size_t)blockIdx.x * 512 + tid; i < (size_t)MTOT * DM; i += (size_t)G * 512) o[i] = bf2f(da[i]) + bf2f(db[i % ((size_t)MG * 1024)]);
            return;
        }
#endif
    }
}

extern "C" void kernel_launch(void* const* d_in, const int* in_sizes, int n_in, void* d_out, int out_size, void* d_ws, size_t ws_size, hipStream_t stream) {
    static int grid_blocks = 0;
    if (grid_blocks == 0) {
        if (n_in != 24 || out_size != MTOT * DM || ws_size < WS_END) { fprintf(stderr, "kernel_launch: unexpected shapes (n_in %d out %d ws %zu need %zu)\n", n_in, out_size, ws_size, (size_t)WS_END); grid_blocks = -1; return; }
        int dev = 0, cus = 0, per_cu = 0;
        (void)hipGetDevice(&dev); (void)hipDeviceGetAttribute(&cus, hipDeviceAttributeMultiprocessorCount, dev);
        if (hipFuncSetAttribute((const void*)fwd_megakernel, hipFuncAttributeMaxDynamicSharedMemorySize, LDS_BYTES) != hipSuccess) { fprintf(stderr, "kernel_launch: hipFuncSetAttribute failed\n"); grid_blocks = -1; return; }
        if (hipOccupancyMaxActiveBlocksPerMultiprocessor(&per_cu, (const void*)fwd_megakernel, 512, LDS_BYTES) != hipSuccess || per_cu < 1) per_cu = 1;
        (void)hipGetLastError();
        grid_blocks = cus * per_cu;
    }
    if (grid_blocks < 0) return;
    (void)hipMemsetAsync((unsigned char*)d_ws + WS_CTL, 0, CTL_BYTES, stream);
    Params p{};
    for (int i = 0; i < 24; ++i) p.in[i] = (const float*)d_in[i];
    p.out = (float*)d_out; p.ws = (unsigned char*)d_ws;
    void* args[] = {&p};
    hipError_t e = hipLaunchCooperativeKernel((const void*)fwd_megakernel, dim3(grid_blocks), dim3(512), args, LDS_BYTES, stream);
    if (e != hipSuccess) fprintf(stderr, "cooperative launch failed: %s (grid %d)\n", hipGetErrorString(e), grid_blocks);
}
```
